# Optimizing an MI355X kernel written in HIP

```python
import math
import jax, jax.numpy as jnp
from jax import lax
import numpy as np

D_MODEL = 2048
BATCH = 1
SEQ = 8192
DEPTH = 2

N_BRANCH = 4
BR_WIDTH = 512
LRU_BLOCKS = 8
LRU_BLOCK = BR_WIDTH // LRU_BLOCKS
LRU_CONV = 4
LRU_C = 8.0
ATT_GROUPS = ((128, 1), (512, 4), (2048, 16))
ATT_HEADS_PER_GROUP = 4
ATT_HEAD_DIM = BR_WIDTH // ATT_HEADS_PER_GROUP
ATT_HEADS = len(ATT_GROUPS) * ATT_HEADS_PER_GROUP
ATT_QKV = ATT_HEADS * ATT_HEAD_DIM
ATT_SPAN = 128
N_BUCKETS = 32
MAX_DISTANCE = 2048
NEG_INF = -1e30
RWKV_HEAD = 64
RWKV_HEADS = BR_WIDTH // RWKV_HEAD
DECAY_RANK = 64
ICLR_RANK = 64
RWKV_GN_EPS = 64e-5
RWKV_SHIFT_W = 3 * BR_WIDTH + DECAY_RANK + ICLR_RANK
CONF_KERNEL = 31
LN_EPS = 1e-5
ALPHA = (2.0 * DEPTH) ** 0.25
BETA = (8.0 * DEPTH) ** -0.25

IN_SPLITS = (
    BR_WIDTH, BR_WIDTH,
    ATT_QKV, ATT_QKV, ATT_QKV, BR_WIDTH,
    BR_WIDTH, BR_WIDTH, BR_WIDTH, DECAY_RANK, ICLR_RANK, BR_WIDTH,
    BR_WIDTH, BR_WIDTH, BR_WIDTH,
    N_BRANCH * D_MODEL,
)
D_IN = sum(IN_SPLITS)

kernel_name = 'hybrid_rglru_dilattn_rwkv7_conformer_deepnorm'


def _layernorm(x, g, b, eps=LN_EPS):
    xf = x.astype(jnp.float32)
    mu = xf.mean(-1, keepdims=True)
    var = jnp.square(xf - mu).mean(-1, keepdims=True)
    return ((xf - mu) * lax.rsqrt(var + eps) * g + b).astype(x.dtype)


def _causal_depthwise_conv(x, w, b):
    width, ch = w.shape
    y = lax.conv_general_dilated(x, w[:, None, :], window_strides=(1,), padding=[(width - 1, 0)],
                                 dimension_numbers=('NWC', 'WIO', 'NWC'), feature_group_count=ch)
    return y + b


def _linear_scan(a, b):
    def op(c1, c2):
        a1, b1 = c1
        a2, b2 = c2
        return a1 * a2, a2 * b1 + b2
    _, h = lax.associative_scan(op, (a, b), axis=1)
    return h


def _rwkv7_scan(r, w, k, v, a, b):
    bsz, _, nh, n = r.shape
    def step(state, inp):
        r_t, w_t, k_t, v_t, a_t, b_t = inp
        sa = jnp.einsum('bhij,bhj->bhi', state, a_t)
        state = state * w_t[:, :, None, :] + sa[..., :, None] * b_t[:, :, None, :] + v_t[..., :, None] * k_t[:, :, None, :]
        return state, jnp.einsum('bhij,bhj->bhi', state, r_t)
    xs = tuple(jnp.moveaxis(t, 1, 0) for t in (r, w, k, v, a, b))
    s0 = jnp.zeros((bsz, nh, n, n), jnp.float32)
    _, ys = lax.scan(step, s0, xs)
    return jnp.moveaxis(ys, 0, 1)


def _t5_bucket(dist):
    max_exact = N_BUCKETS // 2
    large = max_exact + (np.log(np.maximum(dist, 1) / max_exact) / math.log(MAX_DISTANCE / max_exact)
                         * (N_BUCKETS - max_exact)).astype(np.int32)
    large = np.minimum(large, N_BUCKETS - 1)
    return np.where(dist < max_exact, dist, large).astype(np.int32)


def _group_bias(table, dilation):
    qi = np.arange(ATT_SPAN)[:, None]
    kj = np.arange(2 * ATT_SPAN)[None, :]
    dist = qi + ATT_SPAN - kj
    valid = (dist >= 0) & (dist <= ATT_SPAN)
    bucket = _t5_bucket(np.clip(dist, 0, ATT_SPAN) * dilation)
    bias = jnp.where(valid[..., None], table[bucket].astype(jnp.float32), NEG_INF)
    return jnp.transpose(bias, (0, 2, 1))


def _dilated_window_attention(q, k, v, bias, dilation):
    bsz, s, h, dh = q.shape
    m_rows = s // dilation
    nb = -(-m_rows // ATT_SPAN)
    mp = nb * ATT_SPAN

    def to_res(t):
        t = jnp.transpose(t.reshape(bsz, m_rows, dilation, h, dh), (0, 2, 1, 3, 4))
        t = jnp.pad(t, ((0, 0), (0, 0), (0, mp - m_rows), (0, 0), (0, 0)))
        return t.reshape(bsz, dilation, nb, ATT_SPAN, h, dh)

    def with_prev(t):
        prev = jnp.pad(t, ((0, 0), (0, 0), (1, 0), (0, 0), (0, 0), (0, 0)))[:, :, :-1]
        return jnp.concatenate([prev, t], axis=3)

    qb = to_res(q).astype(jnp.float32)
    kw = with_prev(to_res(k)).astype(jnp.float32)
    vw = with_prev(to_res(v)).astype(jnp.float32)
    logits = jnp.einsum('brnqhd,brnkhd->brnqhk', qb, kw) * (dh ** -0.5) + bias
    first = (np.arange(nb)[:, None] == 0) & (np.arange(2 * ATT_SPAN)[None, :] < ATT_SPAN)
    logits = jnp.where(first[:, None, None, :], NEG_INF, logits)
    m = logits.max(-1)
    p = jnp.exp(logits - m[..., None])
    den = p.sum(-1)
    o = jnp.einsum('brnqhk,brnkhd->brnqhd', p, vw) / den[..., None]

    def from_res(t):
        t = t.reshape((bsz, dilation, mp) + t.shape[4:])[:, :, :m_rows]
        t = jnp.moveaxis(t, 1, 2)
        return t.reshape((bsz, s) + t.shape[3:])

    return from_res(o), from_res(m), from_res(den)


def _hybrid_layer(x, rel_bias, w_in, b_in, lru_conv_w, lru_conv_b, lru_gate_a_w, lru_gate_a_b,
                  lru_gate_x_w, lru_gate_x_b, lru_lambda, rwkv_mu, rwkv_w0, rwkv_w_up, rwkv_a0, rwkv_a_up,
                  rwkv_k_k, rwkv_k_a, rwkv_r_k, rwkv_gn_g, rwkv_gn_b, conf_dw_w, conf_dw_b, conf_ln_g,
                  conf_ln_b, w_br, w_out, ln_g, ln_b):
    bsz, s, _ = x.shape
    dt = x.dtype
    f32 = jnp.float32
    split_points = np.cumsum(IN_SPLITS)[:-1].tolist()
    h = jnp.einsum('bsd,de->bse', x, w_in) + b_in
    (a_x, a_gate, q, k, v, b_gate, c_r, c_k, c_v, c_wd, c_ad, c_gate,
     d_val, d_glu, d_gate, merge_logits) = jnp.split(h, split_points, axis=-1)

    u = _causal_depthwise_conv(a_x, lru_conv_w, lru_conv_b)
    ub = u.reshape(bsz, s, LRU_BLOCKS, LRU_BLOCK)
    gate_r = jax.nn.sigmoid(jnp.einsum('bsgi,gij->bsgj', ub, lru_gate_a_w).reshape(bsz, s, BR_WIDTH) + lru_gate_a_b)
    gate_i = jax.nn.sigmoid(jnp.einsum('bsgi,gij->bsgj', ub, lru_gate_x_w).reshape(bsz, s, BR_WIDTH) + lru_gate_x_b)
    log_a = -LRU_C * gate_r.astype(f32) * jax.nn.softplus(-lru_lambda.astype(f32))
    a_t = jnp.exp(log_a)
    mult = jnp.sqrt(-jnp.expm1(2.0 * log_a))
    y_a = _linear_scan(a_t, mult * (gate_i * u).astype(f32)).astype(dt)

    qh = q.reshape(bsz, s, ATT_HEADS, ATT_HEAD_DIM)
    kh = k.reshape(bsz, s, ATT_HEADS, ATT_HEAD_DIM)
    vh = v.reshape(bsz, s, ATT_HEADS, ATT_HEAD_DIM)
    outs, maxes, dens = [], [], []
    for g, (window, dil) in enumerate(ATT_GROUPS):
        hs = slice(g * ATT_HEADS_PER_GROUP, (g + 1) * ATT_HEADS_PER_GROUP)
        bias = _group_bias(rel_bias[:, hs], dil)
        o_g, m_g, s_g = _dilated_window_attention(qh[:, :, hs], kh[:, :, hs], vh[:, :, hs], bias, dil)
        outs.append(o_g)
        maxes.append(m_g)
        dens.append(s_g)
    m_all = jnp.stack(maxes)
    wts = jnp.exp(m_all - m_all.max(0)) * jnp.stack(dens)
    y_b = (wts[..., None] * jnp.stack(outs)).sum(0) / wts.sum(0)[..., None]
    y_b = y_b.reshape(bsz, s, BR_WIDTH).astype(dt)

    c_in = jnp.concatenate([c_r, c_k, c_v, c_wd, c_ad], axis=-1)
    c_prev = jnp.pad(c_in, ((0, 0), (1, 0), (0, 0)))[:, :-1]
    c_in = c_in + rwkv_mu * (c_prev - c_in)
    r, kx, vv, wd, ad = jnp.split(c_in, [BR_WIDTH, 2 * BR_WIDTH, 3 * BR_WIDTH, 3 * BR_WIDTH + DECAY_RANK], axis=-1)
    w_log = -jax.nn.softplus(-(rwkv_w0 + jnp.tanh(wd) @ rwkv_w_up).astype(f32)) - 0.5
    decay = jnp.exp(-jnp.exp(w_log))
    a_icl = jax.nn.sigmoid((rwkv_a0 + ad @ rwkv_a_up).astype(f32))

    def heads(t):
        return t.reshape(bsz, s, RWKV_HEADS, RWKV_HEAD)

    kxf = kx.astype(f32)
    kk = heads(kxf * rwkv_k_k)
    kk = kk / jnp.maximum(jnp.sqrt(jnp.sum(kk * kk, -1, keepdims=True)), 1e-12)
    kc = heads(kxf * (1.0 + (a_icl - 1.0) * rwkv_k_a))
    rh = heads(r.astype(f32))
    vf = heads(vv.astype(f32))
    wy = _rwkv7_scan(rh, heads(decay), kc, vf, -kk, kk * heads(a_icl))
    mu = wy.mean(-1, keepdims=True)
    var = jnp.square(wy - mu).mean(-1, keepdims=True)
    wy = ((wy - mu) * lax.rsqrt(var + RWKV_GN_EPS)).reshape(bsz, s, BR_WIDTH) * rwkv_gn_g + rwkv_gn_b
    bonus = jnp.sum(rh * kc * rwkv_r_k, -1, keepdims=True) * vf
    y_c = (wy + bonus.reshape(bsz, s, BR_WIDTH)).astype(dt)

    cu = d_val * jax.nn.sigmoid(d_glu)
    cu = _causal_depthwise_conv(cu, conf_dw_w, conf_dw_b)
    y_d = jax.nn.silu(_layernorm(cu, conf_ln_g, conf_ln_b))

    merge_g = jax.nn.sigmoid(merge_logits).reshape(bsz, s, N_BRANCH, D_MODEL)
    ys = (y_a, y_b, y_c, y_d)
    gates = (a_gate, b_gate, c_gate, d_gate)
    mixed = jnp.zeros_like(x)
    for n in range(N_BRANCH):
        mixed = mixed + merge_g[:, :, n] * jnp.einsum('bsc,cd->bsd', ys[n] * jax.nn.silu(gates[n]), w_br[n])
    out = jnp.einsum('bsd,de->bse', mixed, w_out)
    return _layernorm(ALPHA * x + out, ln_g, ln_b)


def setup_inputs(seed: int = 0) -> dict:
    key = jax.random.key(seed)
    ks = jax.random.split(key, 32)
    f32 = jnp.float32

    def nrm(k, shape, scale):
        return jax.random.normal(k, shape, f32) * scale

    def unif(k, shape, lo, hi):
        return jax.random.uniform(k, shape, f32, lo, hi)

    a_target = unif(ks[10], (DEPTH, BR_WIDTH), 0.9, 0.999)
    s_lam = a_target ** (1.0 / LRU_C)
    return {
        'x': nrm(ks[0], (BATCH, SEQ, D_MODEL), 1.0),
        'att_rel_bias': nrm(ks[1], (N_BUCKETS, ATT_HEADS), 0.1),
        'w_in': nrm(ks[2], (DEPTH, D_MODEL, D_IN), D_MODEL ** -0.5),
        'b_in': nrm(ks[3], (DEPTH, D_IN), 0.02),
        'lru_conv_w': nrm(ks[4], (DEPTH, LRU_CONV, BR_WIDTH), LRU_CONV ** -0.5),
        'lru_conv_b': nrm(ks[5], (DEPTH, BR_WIDTH), 0.02),
        'lru_gate_a_w': nrm(ks[6], (DEPTH, LRU_BLOCKS, LRU_BLOCK, LRU_BLOCK), LRU_BLOCK ** -0.5),
        'lru_gate_a_b': nrm(ks[7], (DEPTH, BR_WIDTH), 0.02),
        'lru_gate_x_w': nrm(ks[8], (DEPTH, LRU_BLOCKS, LRU_BLOCK, LRU_BLOCK), LRU_BLOCK ** -0.5),
        'lru_gate_x_b': nrm(ks[9], (DEPTH, BR_WIDTH), 0.02),
        'lru_lambda': jnp.log(s_lam) - jnp.log1p(-s_lam),
        'rwkv_mu': unif(ks[11], (DEPTH, RWKV_SHIFT_W), 0.0, 1.0),
        'rwkv_w0': jnp.linspace(-6.5, -1.5, BR_WIDTH, dtype=f32)[None, :] + nrm(ks[12], (DEPTH, BR_WIDTH), 0.1),
        'rwkv_w_up': nrm(ks[13], (DEPTH, DECAY_RANK, BR_WIDTH), 0.5 * DECAY_RANK ** -0.5),
        'rwkv_a0': nrm(ks[14], (DEPTH, BR_WIDTH), 0.1),
        'rwkv_a_up': nrm(ks[15], (DEPTH, ICLR_RANK, BR_WIDTH), 0.5 * ICLR_RANK ** -0.5),
        'rwkv_k_k': 0.85 + nrm(ks[16], (DEPTH, BR_WIDTH), 0.02),
        'rwkv_k_a': 1.0 + nrm(ks[17], (DEPTH, BR_WIDTH), 0.02),
        'rwkv_r_k': nrm(ks[18], (DEPTH, RWKV_HEADS, RWKV_HEAD), 0.1),
        'rwkv_gn_g': 1.0 + nrm(ks[19], (DEPTH, BR_WIDTH), 0.02),
        'rwkv_gn_b': nrm(ks[20], (DEPTH, BR_WIDTH), 0.02),
        'conf_dw_w': nrm(ks[21], (DEPTH, CONF_KERNEL, BR_WIDTH), CONF_KERNEL ** -0.5),
        'conf_dw_b': nrm(ks[22], (DEPTH, BR_WIDTH), 0.02),
        'conf_ln_g': 1.0 + nrm(ks[23], (DEPTH, BR_WIDTH), 0.02),
        'conf_ln_b': nrm(ks[24], (DEPTH, BR_WIDTH), 0.02),
        'w_br': nrm(ks[25], (DEPTH, N_BRANCH, BR_WIDTH, D_MODEL), BR_WIDTH ** -0.5),
        'w_out': nrm(ks[26], (DEPTH, D_MODEL, D_MODEL), BETA * D_MODEL ** -0.5),
        'ln_g': 1.0 + nrm(ks[27], (DEPTH, D_MODEL), 0.02),
        'ln_b': nrm(ks[28], (DEPTH, D_MODEL), 0.02),
    }


def reference(x, att_rel_bias, w_in, b_in, lru_conv_w, lru_conv_b, lru_gate_a_w, lru_gate_a_b,
              lru_gate_x_w, lru_gate_x_b, lru_lambda, rwkv_mu, rwkv_w0, rwkv_w_up, rwkv_a0, rwkv_a_up,
              rwkv_k_k, rwkv_k_a, rwkv_r_k, rwkv_gn_g, rwkv_gn_b, conf_dw_w, conf_dw_b, conf_ln_g,
              conf_ln_b, w_br, w_out, ln_g, ln_b):
    for l in range(DEPTH):
        x = _hybrid_layer(x, att_rel_bias, w_in[l], b_in[l], lru_conv_w[l], lru_conv_b[l], lru_gate_a_w[l],
                          lru_gate_a_b[l], lru_gate_x_w[l], lru_gate_x_b[l], lru_lambda[l], rwkv_mu[l],
                          rwkv_w0[l], rwkv_w_up[l], rwkv_a0[l], rwkv_a_up[l], rwkv_k_k[l], rwkv_k_a[l],
                          rwkv_r_k[l], rwkv_gn_g[l], rwkv_gn_b[l], conf_dw_w[l], conf_dw_b[l], conf_ln_g[l],
                          conf_ln_b[l], w_br[l], w_out[l], ln_g[l], ln_b[l])
    return x
```

```cpp
#include <hip/hip_runtime.h>
#include <cstdio>
#include <cstdint>

#ifndef MK_ONE_LAUNCH
#define MK_ONE_LAUNCH 1
#endif
#ifndef PH_MASK
#define PH_MASK 0xFFFF
#endif

#define LAS __attribute__((address_space(3)))
#define GAS __attribute__((address_space(1)))
typedef unsigned short bf16_t;
typedef short bf16x8 __attribute__((ext_vector_type(8)));
typedef float f32x4 __attribute__((ext_vector_type(4)));
typedef float f32x2 __attribute__((ext_vector_type(2)));
typedef unsigned u32x4 __attribute__((ext_vector_type(4)));
typedef unsigned u32x2 __attribute__((ext_vector_type(2)));

constexpr int SEQ = 8192, DM = 2048, DEPTH = 2, BW = 512, D_IN = 18048;
constexpr int NSPLIT = 9856;
constexpr int NH = 9984;
constexpr int NPAD = NH + 8192;
constexpr int NT_H = NH / 256;
constexpr int O_AX = 0, O_AG = 512, O_Q = 1024, O_K = 2560, O_V = 4096, O_BG = 5632, O_CR = 6144, O_CK = 6656, O_CV = 7168, O_CWD = 7680,
              O_CAD = 7744, O_CG = 7808, O_DV = 8320, O_DGLU = 8832, O_DG = 9344;
constexpr float ALPHA = 1.41421356237309515f;
constexpr float LN_EPS = 1e-5f, GN_EPS = 64e-5f;

__device__ __forceinline__ float bf2f(unsigned b) { return __uint_as_float(b << 16); }
__device__ __forceinline__ unsigned f2bf(float f) { unsigned u = __float_as_uint(f); return (u + 0x7fffu + ((u >> 16) & 1u)) >> 16; }
__device__ __forceinline__ unsigned pk2(float lo, float hi) { return f2bf(lo) | (f2bf(hi) << 16); }
__device__ __forceinline__ float wlo(unsigned w) { return __uint_as_float(w << 16); }
__device__ __forceinline__ float whi(unsigned w) { return __uint_as_float(w & 0xffff0000u); }
__device__ __forceinline__ float sigm(float x) { return 1.f / (1.f + __expf(-x)); }
__device__ __forceinline__ float silu(float x) { return x / (1.f + __expf(-x)); }
__device__ __forceinline__ float softplusf(float y) { return fmaxf(y, 0.f) + log1pf(__expf(-fabsf(y))); }
__device__ __forceinline__ float wave_sum(float v) {
#pragma unroll
    for (int o = 1; o < 64; o <<= 1) v += __shfl_xor(v, o);
    return v;
}

namespace pg8 {
constexpr int BM = 256, BK = 64, HALF = 128, HTB = HALF * BK * 2, STAGE_BYTES = 8 * HTB, NXCD = 8, WGM = 8;
__host__ __device__ __forceinline__ int lds_byte(int r, int c) { const int st = (r >> 4) * 2 + (c >> 5), rr = r & 15, cc = c & 31, ob = rr * 64 + cc * 2; return st * 1024 + (ob ^ (((ob >> 9) & 1) << 5)); }
__host__ __device__ __forceinline__ void stage_rc(int b, int& R, int& C) { const int st = b / 1024, sb = b % 1024, swz = sb ^ (((sb >> 9) & 1) << 5); R = (st >> 1) * 16 + swz / 64; C = (st & 1) * 32 + (swz % 64) / 2; }
__host__ __device__ __forceinline__ int perm32(int rho) { const int n = rho >> 4, i = rho & 15; return 8 * (i >> 2) + 4 * n + (i & 3); }

struct Unit { int pm, pn; };
struct Gemm { const bf16_t* A; const bf16_t* Bt; int M, N, K, lda, ldb; };

struct StaticOrder {
    int nM, nN, nwg, G, c;
    __device__ void init(int M, int N, int G_, int c_) { nM = M / BM; nN = N / BM; nwg = nM * nN; G = G_; c = c_; }
    __device__ bool next(int i, Unit& u) const {
        const long L = (long)i * G + c; if (L >= nwg) return false;
        int wgid = (int)L; { const int q = nwg / NXCD, r = nwg % NXCD, xcd = wgid % NXCD, off = wgid / NXCD; wgid = (xcd < r ? xcd * (q + 1) : r * (q + 1) + (xcd - r) * q) + off; }
        const int nig = WGM * nN, gid = wgid / nig, fm = gid * WGM, gsz = (nM - fm) < WGM ? (nM - fm) : WGM;
        u.pm = fm + ((wgid % nig) % gsz); u.pn = (wgid % nig) / gsz; return true;
    }
};

__device__ __forceinline__ unsigned cvt_pk_bf16(float lo, float hi) { unsigned r; asm volatile("v_cvt_pk_bf16_f32 %0, %1, %2" : "=v"(r) : "v"(lo), "v"(hi)); return r; }


struct EpiIn {
    static constexpr bool PERM = true;
    bf16_t* H; bf16_t* G; const float* bias;
    __device__ __forceinline__ void operator()(const f32x4 (&acc)[2][2][4][2], const Unit& u, int wr, int wc, int fr, int fq) const {
        const int row0 = u.pm * BM + wr * 64 + fr, bcol0 = u.pn * BM + wc * 32 + 8 * fq;
        const bool isg = u.pn >= NT_H;
        bf16_t* base = isg ? G : H; const int ldc = isg ? 8192 : NH; const int col0 = isg ? bcol0 - NH : bcol0;
        f32x4 bv[2][2];
#pragma unroll
        for (int bj = 0; bj < 2; ++bj)
#pragma unroll
            for (int n = 0; n < 2; ++n) bv[bj][n] = *(const f32x4*)(bias + bcol0 + bj * HALF + 4 * n);
#pragma unroll
        for (int ai = 0; ai < 2; ++ai)
#pragma unroll
            for (int m = 0; m < 4; ++m) { bf16_t* rowp = base + (size_t)(row0 + ai * HALF + m * 16) * ldc + col0;
#pragma unroll
                for (int bj = 0; bj < 2; ++bj) { f32x4 v0 = acc[ai][bj][m][0] + bv[bj][0], v1 = acc[ai][bj][m][1] + bv[bj][1];
                    if (isg) {
#pragma unroll
                        for (int e = 0; e < 4; ++e) { v0[e] = __builtin_amdgcn_rcpf(1.f + __expf(-v0[e])); v1[e] = __builtin_amdgcn_rcpf(1.f + __expf(-v1[e])); } }
                    u32x4 w; w.x = cvt_pk_bf16(v0[0], v0[1]); w.y = cvt_pk_bf16(v0[2], v0[3]); w.z = cvt_pk_bf16(v1[0], v1[1]); w.w = cvt_pk_bf16(v1[2], v1[3]);
                    *(u32x4*)(rowp + bj * HALF) = w; } }
    }
};
template <int MODE> struct EpiMix {
    static constexpr bool PERM = true;
    const bf16_t* G; int gcol; float* MIXF; bf16_t* MIX;
    __device__ __forceinline__ void operator()(const f32x4 (&acc)[2][2][4][2], const Unit& u, int wr, int wc, int fr, int fq) const {
        const int row0 = u.pm * BM + wr * 64 + fr, col0 = u.pn * BM + wc * 32 + 8 * fq;
#pragma unroll
        for (int ai = 0; ai < 2; ++ai)
#pragma unroll
            for (int m = 0; m < 4; ++m) { const size_t row = (size_t)(row0 + ai * HALF + m * 16);
#pragma unroll
                for (int bj = 0; bj < 2; ++bj) { const int c = col0 + bj * HALF;
                    const u32x4 gv = *(const u32x4*)(G + row * 8192 + gcol + c);
                    f32x4 v0 = acc[ai][bj][m][0], v1 = acc[ai][bj][m][1];
                    v0[0] *= wlo(gv.x); v0[1] *= whi(gv.x); v0[2] *= wlo(gv.y); v0[3] *= whi(gv.y);
                    v1[0] *= wlo(gv.z); v1[1] *= whi(gv.z); v1[2] *= wlo(gv.w); v1[3] *= whi(gv.w);
                    float* mp = MIXF + row * DM + c;
                    if (MODE >= 1) { v0 += *(const f32x4*)mp; v1 += *(const f32x4*)(mp + 4); }
                    if (MODE <= 1) { *(f32x4*)mp = v0; *(f32x4*)(mp + 4) = v1; }
                    else { u32x4 w; w.x = cvt_pk_bf16(v0[0], v0[1]); w.y = cvt_pk_bf16(v0[2], v0[3]); w.z = cvt_pk_bf16(v1[0], v1[1]); w.w = cvt_pk_bf16(v1[2], v1[3]);
                        *(u32x4*)(MIX + row * DM + c) = w; } }
                asm volatile("" ::: "memory"); }
    }
};
struct EpiOut {
    static constexpr bool PERM = true;
    const float* xres; float* Z;
    __device__ __forceinline__ void operator()(const f32x4 (&acc)[2][2][4][2], const Unit& u, int wr, int wc, int fr, int fq) const {
        const int row0 = u.pm * BM + wr * 64 + fr, col0 = u.pn * BM + wc * 32 + 8 * fq;
#pragma unroll
        for (int ai = 0; ai < 2; ++ai)
#pragma unroll
            for (int m = 0; m < 4; ++m) { const size_t row = (size_t)(row0 + ai * HALF + m * 16);
#pragma unroll
                for (int bj = 0; bj < 2; ++bj) { const size_t off = row * DM + col0 + bj * HALF;
                    const f32x4 x0 = *(const f32x4*)(xres + off), x1 = *(const f32x4*)(xres + off + 4);
                    *(f32x4*)(Z + off) = x0 * ALPHA + acc[ai][bj][m][0]; *(f32x4*)(Z + off + 4) = x1 * ALPHA + acc[ai][bj][m][1]; }
                asm volatile("" ::: "memory"); }
    }
};

template <class Epi, class Sched, bool ALIGN_EPI>
__device__ __forceinline__ void gemm_phase(LAS unsigned char* lds, const Gemm g, const Sched& S, const Epi& E, const int tid) {
    const int wid = __builtin_amdgcn_readfirstlane(tid >> 6), lane = tid & 63, wr = wid >> 2, wc = wid & 3, fr = lane & 15, fq = lane >> 4;
    const int K = g.K, nt = K / BK;
    unsigned voffA[2], voffB[2];
#pragma unroll
    for (int i = 0; i < 2; ++i) { int R, C; stage_rc(tid * 16 + i * 8192, R, C); const int Rb = Epi::PERM ? ((R & ~31) + perm32(R & 31)) : R;
        voffA[i] = (unsigned)(R * g.lda + C) * 2u; voffB[i] = (unsigned)(Rb * g.ldb + C) * 2u; }
    const size_t kstep = (size_t)(BK * 2);
    const size_t hstepA = (size_t)HALF * g.lda * 2, hstepB = (size_t)HALF * g.ldb * 2;
    const size_t tstepA = 2 * hstepA, tstepB = 2 * hstepB;
    const unsigned ldsw = (unsigned)wid * 1024u;
    const int aoff = lds_byte(wr * 64 + fr, fq * 8), boff = lds_byte(wc * 32 + fr, fq * 8);
#define PG8_SA(b, h) (((b) * 2 + (h)) * HTB)
#define PG8_SB(b, h) ((4 + (b) * 2 + (h)) * HTB)
#define PG8_STAGE(bufoff, gbase, voff) do { _Pragma("unroll") for (int _i = 0; _i < 2; ++_i) \
        __builtin_amdgcn_global_load_lds((const unsigned*)((const char*)(gbase) + (voff)[_i]), (LAS unsigned*)(lds + (bufoff) + ldsw + _i * 8192), 16, 0, 0); } while (0)
#define PG8_LDA(dst, b, h) do { _Pragma("unroll") for (int m = 0; m < 4; ++m) _Pragma("unroll") for (int k = 0; k < 2; ++k) dst[m][k] = *(const LAS bf16x8*)(lds + PG8_SA(b, h) + aoff + m * 2048 + k * 1024); } while (0)
#define PG8_LDB(dst, b, h) do { _Pragma("unroll") for (int n = 0; n < 2; ++n) _Pragma("unroll") for (int k = 0; k < 2; ++k) dst[n][k] = *(const LAS bf16x8*)(lds + PG8_SB(b, h) + boff + n * 2048 + k * 1024); } while (0)
#define PG8_MMA(ai, bj, At, Bt) do { __builtin_amdgcn_s_setprio(1); _Pragma("unroll") for (int m = 0; m < 4; ++m) _Pragma("unroll") for (int n = 0; n < 2; ++n) _Pragma("unroll") for (int k = 0; k < 2; ++k) \
        acc[ai][bj][m][n] = __builtin_amdgcn_mfma_f32_16x16x32_bf16(Bt[n][k], At[m][k], acc[ai][bj][m][n], 0, 0, 0); __builtin_amdgcn_s_setprio(0); } while (0)
#define PG8_WAIT_V(n) asm volatile("s_waitcnt vmcnt(" #n ")" ::: "memory")
#define PG8_WAIT_L(n) asm volatile("s_waitcnt lgkmcnt(" #n ")" ::: "memory")
#define PG8_BAR __builtin_amdgcn_s_barrier()
#define PG8_SCHED __builtin_amdgcn_sched_barrier(0)
    Unit cur, nxt; int ui = 0;
    if (!S.next(0, cur)) return;
    f32x4 acc[2][2][4][2];
#pragma unroll
    for (int a = 0; a < 2; ++a)
#pragma unroll
        for (int b = 0; b < 2; ++b)
#pragma unroll
            for (int m = 0; m < 4; ++m)
#pragma unroll
                for (int n = 0; n < 2; ++n) acc[a][b][m][n] = (f32x4){0.f, 0.f, 0.f, 0.f};
    bf16x8 At[4][2], B0[2][2], B1[2][2];
    const char* cA = (const char*)g.A + (size_t)cur.pm * tstepA; const char* cB = (const char*)g.Bt + (size_t)cur.pn * tstepB;
    PG8_STAGE(PG8_SB(0, 0), cB, voffB); PG8_STAGE(PG8_SB(0, 1), cB + hstepB, voffB); PG8_STAGE(PG8_SA(0, 0), cA, voffA); PG8_STAGE(PG8_SA(0, 1), cA + hstepA, voffA);
    if (wr == 1) PG8_BAR;
    PG8_WAIT_V(2); PG8_BAR;
    PG8_STAGE(PG8_SB(1, 0), cB + kstep, voffB); PG8_STAGE(PG8_SA(1, 0), cA + kstep, voffA); PG8_STAGE(PG8_SB(1, 1), cB + hstepB + kstep, voffB);
    PG8_WAIT_V(6); PG8_BAR;
    for (;;) {
        const bool has_next = S.next(ui + 1, nxt);
        const char* nA = has_next ? (const char*)g.A + (size_t)nxt.pm * tstepA : cA; const char* nB = has_next ? (const char*)g.Bt + (size_t)nxt.pn * tstepB : cB;
        for (int t = 0; t < nt; t += 2) {
            const bool last = (t == nt - 2);
            const char* a1 = cA + (size_t)(t + 1) * kstep;
            const char* a2 = last ? nA : cA + (size_t)(t + 2) * kstep; const char* b2 = last ? nB : cB + (size_t)(t + 2) * kstep;
            const char* a3 = a2 + kstep; const char* b3 = b2 + kstep;
            PG8_LDB(B0, 0, 0); PG8_LDB(B1, 0, 1); PG8_SCHED; PG8_LDA(At, 0, 0); PG8_STAGE(PG8_SA(1, 1), a1 + hstepA, voffA);
            PG8_WAIT_V(8); PG8_WAIT_L(0); PG8_BAR; PG8_MMA(0, 0, At, B0); PG8_MMA(0, 1, At, B1); PG8_BAR; PG8_SCHED;
            PG8_LDA(At, 0, 1); PG8_STAGE(PG8_SB(0, 0), b2, voffB); PG8_STAGE(PG8_SB(0, 1), b2 + hstepB, voffB); PG8_STAGE(PG8_SA(0, 0), a2, voffA);
            PG8_WAIT_V(8); PG8_WAIT_L(0); PG8_BAR; PG8_MMA(1, 0, At, B0); PG8_MMA(1, 1, At, B1); PG8_BAR; PG8_SCHED;
            PG8_LDB(B0, 1, 0); PG8_LDB(B1, 1, 1); PG8_SCHED; PG8_LDA(At, 1, 0); PG8_STAGE(PG8_SA(0, 1), a2 + hstepA, voffA);
            PG8_WAIT_V(8); PG8_WAIT_L(0); PG8_BAR; PG8_MMA(0, 0, At, B0); PG8_MMA(0, 1, At, B1); PG8_BAR; PG8_SCHED;
            PG8_LDA(At, 1, 1); PG8_STAGE(PG8_SB(1, 0), b3, voffB); PG8_STAGE(PG8_SB(1, 1), b3 + hstepB, voffB); PG8_STAGE(PG8_SA(1, 0), a3, voffA);
            PG8_WAIT_V(8); PG8_WAIT_L(0); PG8_BAR; PG8_MMA(1, 0, At, B0); PG8_MMA(1, 1, At, B1); PG8_BAR; PG8_SCHED;
        }
        if constexpr (ALIGN_EPI) { if (wr == 0) PG8_BAR; }
        E(acc, cur, wr, wc, fr, fq);
        if (!has_next) break;
#pragma unroll
        for (int a = 0; a < 2; ++a)
#pragma unroll
            for (int b = 0; b < 2; ++b)
#pragma unroll
                for (int m = 0; m < 4; ++m)
#pragma unroll
                    for (int n = 0; n < 2; ++n) acc[a][b][m][n] = (f32x4){0.f, 0.f, 0.f, 0.f};
        cur = nxt; cA = nA; cB = nB; ++ui;
        if constexpr (ALIGN_EPI) { if (wr == 1) PG8_BAR; }
    }
    PG8_WAIT_V(0);
    if constexpr (!ALIGN_EPI) { if (wr == 0) PG8_BAR; }
    PG8_BAR;
#undef PG8_SA
#undef PG8_SB
#undef PG8_STAGE
#undef PG8_LDA
#undef PG8_LDB
#undef PG8_MMA
#undef PG8_WAIT_V
#undef PG8_WAIT_L
#undef PG8_BAR
#undef PG8_SCHED
}
}

constexpr size_t MiB = 1u << 20;
constexpr size_t al256(size_t x) { return (x + 255) & ~(size_t)255; }
constexpr size_t WS_CTL = 0, CTL_ZERO_BYTES = 1 * MiB;
constexpr size_t SZ_WIN = (size_t)NPAD * DM * 2, SZ_W2 = (size_t)DM * DM * 2, SZ_ACT_F32 = (size_t)SEQ * DM * 4, SZ_ACT_BF = (size_t)SEQ * DM * 2, SZ_BR_F32 = (size_t)SEQ * BW * 4;
constexpr size_t WS_WIN = 1 * MiB;
constexpr size_t WS_WBR = WS_WIN + 2 * SZ_WIN;
constexpr size_t WS_WOUT = WS_WBR + 2 * SZ_W2;
constexpr size_t WS_BIN = WS_WOUT + 2 * SZ_W2;
constexpr size_t WS_XB = al256(WS_BIN + 2 * (size_t)NPAD * 4);
constexpr size_t WS_XF = WS_XB + SZ_ACT_BF;
constexpr size_t WS_H = WS_XF + SZ_ACT_F32;
constexpr size_t WS_MIXF = WS_H;
constexpr size_t WS_Z = WS_H + SZ_ACT_F32;
constexpr size_t WS_G = WS_H + (size_t)SEQ * NH * 2;
constexpr size_t WS_YSG = WS_G + (size_t)SEQ * 8192 * 2;
constexpr size_t WS_MIX = WS_YSG + SZ_ACT_BF;
constexpr size_t WS_OG = WS_MIX + SZ_ACT_BF;
constexpr size_t WS_MG = WS_OG + 3 * SZ_BR_F32;
constexpr size_t WS_DG = WS_MG + 3 * (size_t)SEQ * 4 * 4;
constexpr size_t WS_HL = WS_DG + 3 * (size_t)SEQ * 4 * 4;
constexpr size_t WS_CA = WS_HL + SZ_BR_F32;
constexpr size_t WS_SA = WS_CA + SZ_BR_F32;
constexpr size_t WS_SH = WS_SA + 256 * 512 * 4;
constexpr size_t WS_CARRY = WS_SH + 256 * 512 * 4;
constexpr size_t WS_RR = WS_CARRY + 256 * 512 * 4;
constexpr size_t WS_WY = WS_RR + 7 * SZ_BR_F32;
constexpr size_t WS_END = WS_WY + SZ_BR_F32;
static_assert(WS_Z + SZ_ACT_F32 <= WS_G, "MIXF and Z overlay H");

constexpr int RING_BYTES = 143360;
constexpr int MISC_OFF = RING_BYTES + 320;
constexpr int LDS_BYTES = 151552;
constexpr int NWAVES = 8, NTHREADS = 512;

#define XB_TMO      128
#define XB_XCNT(j)  (256  + 64 * (j))
#define XB_XSUB(j)  (1280 + 64 * (j))
#define XB_XGEN(j)  (2304 + 64 * (j))
#define XB_TOP      3328
#define XB_TOPGEN   3392
#define XCD_BAR_WORDS 3456
#define XB_SPIN_CAP (1u << 18)
__device__ __forceinline__ unsigned xb_ld(unsigned* p)              { return __hip_atomic_load(p, __ATOMIC_RELAXED, __HIP_MEMORY_SCOPE_AGENT); }
__device__ __forceinline__ unsigned xb_add(unsigned* p, unsigned v) { return __hip_atomic_fetch_add(p, v, __ATOMIC_RELAXED, __HIP_MEMORY_SCOPE_AGENT); }
__device__ __forceinline__ unsigned xb_xcc_id() { return (unsigned)__builtin_amdgcn_s_getreg((3 << 11) | 20) & 0xFu; }
#define XB_SPIN(cond, bar) do { unsigned _sp = 0; while (cond) { __builtin_amdgcn_s_sleep(1); \
    if ((++_sp & 255u) == 0u) { if (xb_ld(&(bar)[XB_TMO])) break; if (_sp > XB_SPIN_CAP) { atomicAdd(&(bar)[XB_TMO], 1u); break; } } } } while (0)
struct XcdBarrier { unsigned* bar; unsigned x; volatile LAS unsigned* st; };
__device__ __forceinline__ XcdBarrier xcd_barrier_post(unsigned* bar, volatile LAS unsigned* st) {
    XcdBarrier b; b.bar = bar; b.x = xb_xcc_id(); b.st = st;
    if (threadIdx.x == 0) (void)xb_add(&bar[XB_XCNT(b.x)], 1u);
    return b;
}
__device__ __forceinline__ void xcd_barrier_complete(unsigned* bar, unsigned x, unsigned& nloc, unsigned& nx) {
    const unsigned G = gridDim.x * gridDim.y * gridDim.z;
    unsigned sum, cnt, mine, sp = 0u;
    for (;;) {
        sum = 0u; cnt = 0u; mine = 0u;
#pragma unroll
        for (unsigned j = 0; j < 16; ++j) { const unsigned c = xb_ld(&bar[XB_XCNT(j)]); sum += c; cnt += (c > 0u) ? 1u : 0u; mine = (j == x) ? c : mine; }
        if (sum == G) break;
        __builtin_amdgcn_s_sleep(1);
        if ((++sp & 255u) == 0u) { if (xb_ld(&bar[XB_TMO])) break; if (sp > XB_SPIN_CAP) { atomicAdd(&bar[XB_TMO], 1u); break; } }
    }
    nloc = mine > 0u ? mine : 1u; nx = cnt > 0u ? cnt : 1u;
}
__device__ __forceinline__ void xcd_barrier(const XcdBarrier& b) {
    asm volatile("s_waitcnt vmcnt(0)" ::: "memory");
    __syncthreads();
    if (threadIdx.x == 0) {
        unsigned* bar = b.bar; unsigned bx_ = b.x; asm volatile("" : "+s"(bx_));
        __builtin_amdgcn_s_waitcnt(0);
        unsigned nloc = b.st[0], nx = b.st[1];
        if (nloc == 0u) { xcd_barrier_complete(bar, bx_, nloc, nx); b.st[0] = nloc; b.st[1] = nx; }
        const unsigned old = xb_add(&bar[XB_XSUB(bx_)], 1u);
        const unsigned gen = old / nloc;
        if (old + 1u == (gen + 1u) * nloc) {
            __builtin_amdgcn_fence(__ATOMIC_RELEASE, "agent");
            asm volatile("s_waitcnt vmcnt(0)" ::: "memory");
            const unsigned og = xb_add(&bar[XB_TOP], 1u);
            const unsigned tg = og / nx;
            if (og + 1u == (tg + 1u) * nx) xb_add(&bar[XB_TOPGEN], 1u);
            else XB_SPIN(xb_ld(&bar[XB_TOPGEN]) == tg, bar);
            __builtin_amdgcn_fence(__ATOMIC_ACQUIRE, "agent");
            xb_add(&bar[XB_XGEN(bx_)], 1u);
            asm volatile("s_waitcnt vmcnt(0)" ::: "memory");
        } else {
            XB_SPIN(xb_ld(&bar[XB_XGEN(bx_)]) == gen, bar);
            __builtin_amdgcn_fence(__ATOMIC_ACQUIRE, "agent");
            asm volatile("s_waitcnt vmcnt(0)" ::: "memory");
        }
    }
    __syncthreads();
}

struct Args { const float* in[29]; float* out; unsigned char* ws; int ph_lo, ph_hi; };
template <int OFF> __device__ __forceinline__ unsigned long long karg64() {
    auto kp = __builtin_amdgcn_kernarg_segment_ptr(); unsigned long long p;
    asm volatile("s_load_dwordx2 %0, %1, %2\n\ts_waitcnt lgkmcnt(0)" : "=s"(p) : "s"(kp), "i"(OFF) : "memory");
    return p;
}
template <int I> __device__ __forceinline__ const float* in_ptr() { return (const float*)karg64<8 * I>(); }
__device__ __forceinline__ float* out_ptr() { return (float*)karg64<232>(); }
__device__ __forceinline__ unsigned char* ws_ptr() { return (unsigned char*)karg64<240>(); }

#define LDS_WAIT() asm volatile("s_waitcnt lgkmcnt(0)" ::: "memory")

__device__ __forceinline__ void p0_transpose_item(const float* W, int N, bf16_t* WT, int ldt, int coloff, int split, int add, LAS float* scr, int kb, int nb, int lane) {
    const int k0 = 64 * kb, n0 = 32 * nb;
#pragma unroll 8
    for (int i = 0; i < 32; ++i) { const int kk = 2 * i + (lane >> 5); scr[kk * 33 + (lane & 31)] = W[(size_t)(k0 + kk) * N + n0 + (lane & 31)]; }
    LDS_WAIT(); asm volatile("" ::: "memory");
    const int c = lane & 7;
#pragma unroll
    for (int j = 0; j < 4; ++j) { const int n = (lane >> 3) + 8 * j; const LAS float* s = scr + (8 * c) * 33 + n;
        u32x4 o; o.x = pk2(s[0 * 33], s[1 * 33]); o.y = pk2(s[2 * 33], s[3 * 33]); o.z = pk2(s[4 * 33], s[5 * 33]); o.w = pk2(s[6 * 33], s[7 * 33]);
        const int nn = n0 + n, row = nn < split ? nn : nn + add;
        *(u32x4*)(WT + (size_t)row * ldt + coloff + k0 + 8 * c) = o; }
    LDS_WAIT(); asm volatile("" ::: "memory");
}
__device__ __forceinline__ void p0_prologue(LAS unsigned char* lds, int vcu, int G, int wave, int lane, int tid) {
    LAS float* scr = (LAS float*)(lds + wave * 16384);
    const int gw = vcu * NWAVES + wave, NGW = G * NWAVES;
    unsigned char* ws = ws_ptr();
    constexpr int I_IN = (DM / 64) * (D_IN / 32);
    constexpr int I_BR = (BW / 64) * (DM / 32);
    constexpr int I_OUT = (DM / 64) * (DM / 32);
    constexpr int NITEMS = 2 * I_IN + 8 * I_BR + 2 * I_OUT;
    for (int it = gw; it < NITEMS; it += NGW) {
        int r = it;
        if (r < 2 * I_IN) { const int l = r / I_IN; r -= l * I_IN; const int nblk = D_IN / 32;
            p0_transpose_item(in_ptr<2>() + (size_t)l * DM * D_IN, D_IN, (bf16_t*)(ws + WS_WIN + l * SZ_WIN), DM, 0, NSPLIT, NH - NSPLIT, scr, r / nblk, r % nblk, lane); continue; }
        r -= 2 * I_IN;
        if (r < 8 * I_BR) { const int ln = r / I_BR; r -= ln * I_BR; const int l = ln >> 2, n = ln & 3; const int nblk = DM / 32;
            p0_transpose_item(in_ptr<25>() + (size_t)ln * BW * DM, DM, (bf16_t*)(ws + WS_WBR + l * SZ_W2), DM, n * BW, 1 << 30, 0, scr, r / nblk, r % nblk, lane); continue; }
        r -= 8 * I_BR;
        { const int l = r / I_OUT; r -= l * I_OUT; const int nblk = DM / 32;
            p0_transpose_item(in_ptr<26>() + (size_t)l * DM * DM, DM, (bf16_t*)(ws + WS_WOUT + l * SZ_W2), DM, 0, 1 << 30, 0, scr, r / nblk, r % nblk, lane); }
    }
    const int gt = vcu * NTHREADS + tid, NGT = G * NTHREADS;
    for (int i = gt; i < 2 * 32768; i += NGT) { const int l = i >> 15, j = i & 32767;
        *(u32x4*)(ws + WS_WIN + l * SZ_WIN + (size_t)NSPLIT * DM * 2 + (size_t)j * 16) = (u32x4){0u, 0u, 0u, 0u}; }
    for (int i = gt; i < 2 * NPAD; i += NGT) { const int l = i / NPAD, n = i % NPAD; float v = 0.f;
        if (n < NSPLIT) v = in_ptr<3>()[(size_t)l * D_IN + n]; else if (n >= NH) v = in_ptr<3>()[(size_t)l * D_IN + n - (NH - NSPLIT)];
        ((float*)(ws + WS_BIN))[i] = v; }
    const float* x = in_ptr<0>(); bf16_t* xb = (bf16_t*)(ws + WS_XB);
    for (int i = gt; i < SEQ * DM / 8; i += NGT) { const f32x4 a = *(const f32x4*)(x + (size_t)i * 8), b = *(const f32x4*)(x + (size_t)i * 8 + 4);
        u32x4 o; o.x = pk2(a[0], a[1]); o.y = pk2(a[2], a[3]); o.z = pk2(b[0], b[1]); o.w = pk2(b[2], b[3]); *(u32x4*)(xb + (size_t)i * 8) = o; }
}

__device__ __forceinline__ void lru_pre_unit(int l, int unit, LAS unsigned char* lds, int tid) {
    unsigned char* ws = ws_ptr(); const bf16_t* H = (const bf16_t*)(ws + WS_H);
    LAS float* uL = (LAS float*)lds;
    const int c = tid, t0 = unit * 32;
    {
        const float* cw = in_ptr<4>() + (size_t)l * 4 * BW; const float w0 = cw[c], w1 = cw[BW + c], w2 = cw[2 * BW + c], w3 = cw[3 * BW + c], cb = in_ptr<5>()[l * BW + c];
        float x0 = t0 >= 3 ? bf2f(H[(size_t)(t0 - 3) * NH + O_AX + c]) : 0.f, x1 = t0 >= 2 ? bf2f(H[(size_t)(t0 - 2) * NH + O_AX + c]) : 0.f, x2 = t0 >= 1 ? bf2f(H[(size_t)(t0 - 1) * NH + O_AX + c]) : 0.f;
#pragma unroll 8
        for (int tt = 0; tt < 32; ++tt) { const float x3 = bf2f(H[(size_t)(t0 + tt) * NH + O_AX + c]);
            uL[tt * 512 + c] = cb + w0 * x0 + w1 * x1 + w2 * x2 + w3 * x3; x0 = x1; x1 = x2; x2 = x3; }
    }
    __syncthreads();
    const int g = c >> 6, j = c & 63;
    LAS float* aL = uL + 32 * 512;
    const float sp = softplusf(-in_ptr<10>()[l * BW + c]);
    {
        float Wa[64];
        { const float* pa = in_ptr<6>() + ((size_t)(l * 8 + g) * 64) * 64 + j;
#pragma unroll
          for (int i = 0; i < 64; ++i) Wa[i] = pa[i * 64]; }
        const float ba = in_ptr<7>()[l * BW + c];
#pragma unroll 2
        for (int tt = 0; tt < 32; ++tt) {
            float sa = ba;
            const LAS f32x4* up = (const LAS f32x4*)(uL + tt * 512 + g * 64);
#pragma unroll
            for (int i4 = 0; i4 < 16; ++i4) { const f32x4 uu = up[i4]; sa += uu[0] * Wa[4 * i4] + uu[1] * Wa[4 * i4 + 1] + uu[2] * Wa[4 * i4 + 2] + uu[3] * Wa[4 * i4 + 3]; }
            aL[tt * 512 + c] = -8.f * sigm(sa) * sp;
        }
    }
    asm volatile("" ::: "memory");
    float* HL = (float*)(ws + WS_HL); float* CA = (float*)(ws + WS_CA);
    float h = 0.f, ca = 1.f;
    {
        float Wx[64];
        { const float* px = in_ptr<8>() + ((size_t)(l * 8 + g) * 64) * 64 + j;
#pragma unroll
          for (int i = 0; i < 64; ++i) Wx[i] = px[i * 64]; }
        const float bx = in_ptr<9>()[l * BW + c];
#pragma unroll 2
        for (int tt = 0; tt < 32; ++tt) {
            float sx = bx;
            const LAS f32x4* up = (const LAS f32x4*)(uL + tt * 512 + g * 64);
#pragma unroll
            for (int i4 = 0; i4 < 16; ++i4) { const f32x4 uu = up[i4]; sx += uu[0] * Wx[4 * i4] + uu[1] * Wx[4 * i4 + 1] + uu[2] * Wx[4 * i4 + 2] + uu[3] * Wx[4 * i4 + 3]; }
            const float ig = sigm(sx), la = aL[tt * 512 + c], a = __expf(la), mult = sqrtf(-expm1f(2.f * la));
            const float b = mult * ig * uL[tt * 512 + c];
            h = a * h + b; ca *= a;
            HL[(size_t)(t0 + tt) * BW + c] = h; CA[(size_t)(t0 + tt) * BW + c] = ca;
        }
    }
    ((float*)(ws + WS_SA))[unit * BW + c] = ca; ((float*)(ws + WS_SH))[unit * BW + c] = h;
    __syncthreads();
}
__device__ __forceinline__ void lru_carry(int tid) {
    unsigned char* ws = ws_ptr(); const float* SA = (const float*)(ws + WS_SA); const float* SH = (const float*)(ws + WS_SH); float* CARRY = (float*)(ws + WS_CARRY);
    float carry = 0.f;
    for (int tb = 0; tb < 256; tb += 32) {
        float sa[32], sh[32];
#pragma unroll
        for (int i = 0; i < 32; ++i) { sa[i] = SA[(tb + i) * BW + tid]; sh[i] = SH[(tb + i) * BW + tid]; }
#pragma unroll
        for (int i = 0; i < 32; ++i) { CARRY[(tb + i) * BW + tid] = carry; carry = sa[i] * carry + sh[i]; }
    }
}
__device__ __forceinline__ void lru_post_unit(int unit, int tid) {
    unsigned char* ws = ws_ptr(); const bf16_t* H = (const bf16_t*)(ws + WS_H); const float* HL = (const float*)(ws + WS_HL); const float* CA = (const float*)(ws + WS_CA);
    bf16_t* YSG = (bf16_t*)(ws + WS_YSG);
    const float carry = ((const float*)(ws + WS_CARRY))[unit * BW + tid];
#pragma unroll 8
    for (int tt = 0; tt < 32; ++tt) { const size_t t = (size_t)unit * 32 + tt;
        const float h = HL[t * BW + tid] + CA[t * BW + tid] * carry; const float gt = bf2f(H[t * NH + O_AG + tid]);
        YSG[t * DM + tid] = (bf16_t)f2bf(h * silu(gt)); }
}

__device__ __forceinline__ void conf_unit(int l, int unit, LAS unsigned char* lds, int tid, int wave, int lane) {
    unsigned char* ws = ws_ptr(); const bf16_t* H = (const bf16_t*)(ws + WS_H); bf16_t* YSG = (bf16_t*)(ws + WS_YSG);
    LAS float* cu = (LAS float*)lds; LAS float* yL = (LAS float*)(lds + 46 * 512 * 4);
    const int c = tid, t0 = unit * 16;
#pragma unroll 2
    for (int rr = 0; rr < 46; ++rr) { const int t = t0 - 30 + rr; float v = 0.f;
        if (t >= 0) { const float dv = bf2f(H[(size_t)t * NH + O_DV + c]), dg = bf2f(H[(size_t)t * NH + O_DGLU + c]); v = dv * sigm(dg); }
        cu[rr * 512 + c] = v; }
    __syncthreads();
    {
        float w[31]; const float* cw = in_ptr<21>() + (size_t)l * 31 * BW + c;
#pragma unroll
        for (int j = 0; j < 31; ++j) w[j] = cw[j * BW];
        const float cb = in_ptr<22>()[l * BW + c];
        for (int tt = 0; tt < 16; ++tt) { float s = cb;
#pragma unroll
            for (int j = 0; j < 31; ++j) s += w[j] * cu[(tt + j) * 512 + c];
            yL[tt * 512 + c] = s; }
    }
    __syncthreads();
    const float* lg = in_ptr<23>() + l * BW; const float* lb = in_ptr<24>() + l * BW;
#pragma unroll
    for (int q = 0; q < 2; ++q) { const int tt = 2 * wave + q; const size_t t = (size_t)t0 + tt;
        float v[8]; float s = 0.f;
#pragma unroll
        for (int i = 0; i < 8; ++i) { v[i] = yL[tt * 512 + lane + 64 * i]; s += v[i]; }
        const float mean = wave_sum(s) * (1.f / 512.f); float s2 = 0.f;
#pragma unroll
        for (int i = 0; i < 8; ++i) { v[i] -= mean; s2 += v[i] * v[i]; }
        const float rstd = rsqrtf(wave_sum(s2) * (1.f / 512.f) + LN_EPS);
#pragma unroll
        for (int i = 0; i < 8; ++i) { const int ch = lane + 64 * i; const float yn = v[i] * rstd * lg[ch] + lb[ch];
            const float gt = bf2f(H[t * NH + O_DG + ch]);
            YSG[t * DM + 3 * BW + ch] = (bf16_t)f2bf(silu(yn) * silu(gt)); } }
    __syncthreads();
}

__device__ __forceinline__ void rwkv_prep_unit(int l, int unit, LAS unsigned char* lds, int tid) {
    unsigned char* ws = ws_ptr(); const bf16_t* H = (const bf16_t*)(ws + WS_H);
    LAS float* wdad = (LAS float*)lds;
    const int c = tid, t0 = unit * 32;
    const float* mu = in_ptr<11>() + (size_t)l * 1664;
    if (tid < 128) { const float m = mu[1536 + tid]; float prev = t0 > 0 ? bf2f(H[(size_t)(t0 - 1) * NH + O_CWD + tid]) : 0.f;
#pragma unroll 4
        for (int tt = 0; tt < 32; ++tt) { const float cur = bf2f(H[(size_t)(t0 + tt) * NH + O_CWD + tid]); float xs = cur + m * (prev - cur); prev = cur;
            if (tid < 64) xs = tanhf(xs); wdad[tt * 128 + tid] = xs; } }
    __syncthreads();
    float* RR = (float*)(ws + WS_RR);
    {
        float wup[64];
        { const float* pw = in_ptr<13>() + (size_t)l * 64 * BW + c;
#pragma unroll
          for (int i = 0; i < 64; ++i) wup[i] = pw[i * BW]; }
        const float w0c = in_ptr<12>()[l * BW + c];
#pragma unroll 2
        for (int tt = 0; tt < 32; ++tt) { float dw = 0.f; const LAS f32x4* wp = (const LAS f32x4*)(wdad + tt * 128);
#pragma unroll
            for (int i4 = 0; i4 < 16; ++i4) { const f32x4 a = wp[i4]; dw += a[0] * wup[4 * i4] + a[1] * wup[4 * i4 + 1] + a[2] * wup[4 * i4 + 2] + a[3] * wup[4 * i4 + 3]; }
            const float wl = -softplusf(-(w0c + dw)) - 0.5f;
            RR[(size_t)SEQ * BW + (size_t)(t0 + tt) * BW + c] = __expf(-__expf(wl)); }
    }
    asm volatile("" ::: "memory");
    {
        float aup[64];
        { const float* pa = in_ptr<15>() + (size_t)l * 64 * BW + c;
#pragma unroll
          for (int i = 0; i < 64; ++i) aup[i] = pa[i * BW]; }
        const float mr = mu[c], mk = mu[BW + c], mv = mu[2 * BW + c];
        const float a0c = in_ptr<14>()[l * BW + c], kkc = in_ptr<16>()[l * BW + c], kac = in_ptr<17>()[l * BW + c], rkc = in_ptr<18>()[l * BW + c];
        float pr = 0.f, pk = 0.f, pv = 0.f;
        if (t0 > 0) { pr = bf2f(H[(size_t)(t0 - 1) * NH + O_CR + c]); pk = bf2f(H[(size_t)(t0 - 1) * NH + O_CK + c]); pv = bf2f(H[(size_t)(t0 - 1) * NH + O_CV + c]); }
#pragma unroll 2
        for (int tt = 0; tt < 32; ++tt) { const size_t t = (size_t)t0 + tt;
            const float cr = bf2f(H[t * NH + O_CR + c]), ck = bf2f(H[t * NH + O_CK + c]), cv = bf2f(H[t * NH + O_CV + c]);
            const float r = cr + mr * (pr - cr), kx = ck + mk * (pk - ck), vv = cv + mv * (pv - cv); pr = cr; pk = ck; pv = cv;
            float da = 0.f; const LAS f32x4* wp = (const LAS f32x4*)(wdad + tt * 128 + 64);
#pragma unroll
            for (int i4 = 0; i4 < 16; ++i4) { const f32x4 b = wp[i4]; da += b[0] * aup[4 * i4] + b[1] * aup[4 * i4 + 1] + b[2] * aup[4 * i4 + 2] + b[3] * aup[4 * i4 + 3]; }
            const float aicl = sigm(a0c + da);
            const float kkv = kx * kkc, ss = wave_sum(kkv * kkv), kkn = kkv / fmaxf(sqrtf(ss), 1e-12f);
            const float kc = kx * (1.f + (aicl - 1.f) * kac);
            const float bon = wave_sum(r * kc * rkc) * vv;
            const size_t o = t * BW + c;
            RR[o] = r; RR[2 * (size_t)SEQ * BW + o] = kc; RR[3 * (size_t)SEQ * BW + o] = vv;
            RR[4 * (size_t)SEQ * BW + o] = -kkn; RR[5 * (size_t)SEQ * BW + o] = kkn * aicl; RR[6 * (size_t)SEQ * BW + o] = bon;
        }
    }
    __syncthreads();
}

__device__ __forceinline__ float dpp_row_sum_total(float v) {
    v += __builtin_bit_cast(float, __builtin_amdgcn_update_dpp(0, __builtin_bit_cast(int, v), 0xB1, 0xF, 0xF, true));
    v += __builtin_bit_cast(float, __builtin_amdgcn_update_dpp(0, __builtin_bit_cast(int, v), 0x4E, 0xF, 0xF, true));
    v += __builtin_bit_cast(float, __builtin_amdgcn_update_dpp(0, __builtin_bit_cast(int, v), 0x141, 0xF, 0xF, true));
    v += __builtin_bit_cast(float, __builtin_amdgcn_update_dpp(0, __builtin_bit_cast(int, v), 0x140, 0xF, 0xF, true));
    v += __builtin_bit_cast(float, __builtin_amdgcn_update_dpp(0, __builtin_bit_cast(int, v), 0x142, 0xA, 0xF, false));
    v += __builtin_bit_cast(float, __builtin_amdgcn_update_dpp(0, __builtin_bit_cast(int, v), 0x143, 0xC, 0xF, false));
    return __builtin_bit_cast(float, __builtin_amdgcn_readlane(__builtin_bit_cast(int, v), 63));
}
__device__ __forceinline__ void rwkv_scan_unit(int unit, LAS unsigned char* lds, int tid, int wave, int lane) {
    unsigned char* ws = ws_ptr();
    const int h = unit >> 3, i = (unit & 7) * 8 + wave, chi = h * 64 + i;
    const size_t PL = (size_t)SEQ * BW;
    const float* RRb = (const float*)(ws + WS_RR) + h * 64 + 4 * (lane & 15) + (size_t)(lane >> 4) * BW;
    float* WY = (float*)(ws + WS_WY) + (size_t)chi * SEQ;
    constexpr int STG = 6 * 32 * 64 * 4;
    float S = 0.f;
#define RW_ISSUE(st, buf) do { _Pragma("unroll") for (int q_ = 0; q_ < 6; ++q_) { const int id_ = wave * 6 + q_, arr_ = id_ >> 3, tq_ = id_ & 7; const int pl_ = arr_ < 3 ? arr_ : (arr_ == 3 ? 3 : arr_ + 0); \
        __builtin_amdgcn_global_load_lds((const unsigned*)(RRb + (size_t)pl_ * PL + (size_t)((st) * 32 + 4 * tq_) * BW), (LAS unsigned*)(lds + (buf) * STG + (arr_ * 32 + 4 * tq_) * 256), 16, 0, 0); } } while (0)
    RW_ISSUE(0, 0);
    asm volatile("s_waitcnt vmcnt(0)" ::: "memory"); __syncthreads();
    for (int st = 0; st < SEQ / 32; ++st) {
        const int buf = st & 1;
        if (st + 1 < SEQ / 32) RW_ISSUE(st + 1, buf ^ 1);
        const LAS float* Lb = (const LAS float*)(lds + buf * STG);
        float yacc = 0.f;
#pragma unroll 8
        for (int s_ = 0; s_ < 32; ++s_) {
            const float r = Lb[(0 * 32 + s_) * 64 + lane], w = Lb[(1 * 32 + s_) * 64 + lane], k = Lb[(2 * 32 + s_) * 64 + lane], v = Lb[(3 * 32 + s_) * 64 + i],
                        a = Lb[(4 * 32 + s_) * 64 + lane], b = Lb[(5 * 32 + s_) * 64 + lane];
            const float sa = dpp_row_sum_total(S * a);
            S = S * w + (sa * b + v * k);
            const float y = dpp_row_sum_total(S * r);
            yacc = (lane == s_) ? y : yacc;
        }
        if (lane < 32) WY[st * 32 + lane] = yacc;
        asm volatile("s_waitcnt vmcnt(0)" ::: "memory"); __syncthreads();
    }
#undef RW_ISSUE
}
__device__ __forceinline__ void rwkv_post_unit(int l, int unit, LAS unsigned char* lds, int tid, int wave, int lane) {
    unsigned char* ws = ws_ptr(); const bf16_t* H = (const bf16_t*)(ws + WS_H); bf16_t* YSG = (bf16_t*)(ws + WS_YSG);
    const float* WY = (const float*)(ws + WS_WY); const float* BON = (const float*)(ws + WS_RR) + 6 * (size_t)SEQ * BW;
    LAS float* T = (LAS float*)lds;
    const int t0 = unit * 32;
#pragma unroll 4
    for (int k = 0; k < 32; ++k) { const int ch = (tid >> 5) + 16 * k; T[ch * 33 + (tid & 31)] = WY[(size_t)ch * SEQ + t0 + (tid & 31)]; }
    __syncthreads();
    const int ch = wave * 64 + lane; const float gg = in_ptr<19>()[l * BW + ch], gb = in_ptr<20>()[l * BW + ch];
    for (int tt = 0; tt < 32; ++tt) { const size_t t = (size_t)t0 + tt;
        const float v = T[ch * 33 + tt]; const float mean = wave_sum(v) * (1.f / 64.f); const float d = v - mean; const float var = wave_sum(d * d) * (1.f / 64.f);
        const float y = d * rsqrtf(var + GN_EPS) * gg + gb + BON[t * BW + ch];
        const float gt = bf2f(H[t * NH + O_CG + ch]);
        YSG[t * DM + 2 * BW + ch] = (bf16_t)f2bf(y * silu(gt)); }
    __syncthreads();
}

constexpr int ATT_KS = 136, ATT_VS = 260, ATT_K_BYTES = 256 * ATT_KS * 2, ATT_V_BYTES = 128 * ATT_VS * 2;
__device__ __forceinline__ int t5_bucket(int dist) {
    if (dist < 16) return dist;
    const int thr[15] = {22, 30, 40, 54, 73, 99, 134, 182, 246, 332, 450, 609, 825, 1117, 1513};
    int b = 16;
#pragma unroll
    for (int i = 0; i < 15; ++i) b += (dist >= thr[i]) ? 1 : 0;
    return b;
}
__device__ __forceinline__ void att_unit(int unit, LAS unsigned char* lds, int tid, int wave, int lane) {
    unsigned char* ws = ws_ptr(); const bf16_t* H = (const bf16_t*)(ws + WS_H);
    const int g = unit >> 8, hh = (unit >> 6) & 3, b = unit & 63;
    const int dil = g == 0 ? 1 : (g == 1 ? 4 : 16), nb = 64 / dil, r = b / nb, n = b % nb, head = g * 4 + hh;
    LAS bf16_t* Ks = (LAS bf16_t*)lds; LAS bf16_t* Vt = (LAS bf16_t*)(lds + ATT_K_BYTES); LAS float* biasL = (LAS float*)(lds + ATT_K_BYTES + ATT_V_BYTES);
    if (tid < 176) { const int dd = tid - 16; biasL[tid] = (dd >= 0 && dd <= 128) ? in_ptr<1>()[t5_bucket(dd * dil) * 12 + head] : 0.f; }
#pragma unroll 2
    for (int it = 0; it < 8; ++it) { const int idx = it * 512 + tid, key = idx >> 4, chn = idx & 15; const int blk = n - 1 + (key >> 7);
        u32x4 kv = (u32x4){0u, 0u, 0u, 0u}, vv = (u32x4){0u, 0u, 0u, 0u};
        if (blk >= 0) { const size_t t = (size_t)r + (size_t)dil * (128 * blk + (key & 127)); const bf16_t* p = H + t * NH + head * 128 + chn * 8;
            kv = *(const u32x4*)(p + O_K); vv = *(const u32x4*)(p + O_V); }
        *(LAS u32x4*)(Ks + key * ATT_KS + chn * 8) = kv;
        LAS bf16_t* vp = Vt + (chn * 8) * ATT_VS + key;
        vp[0] = (bf16_t)(vv.x & 0xffff); vp[ATT_VS] = (bf16_t)(vv.x >> 16); vp[2 * ATT_VS] = (bf16_t)(vv.y & 0xffff); vp[3 * ATT_VS] = (bf16_t)(vv.y >> 16);
        vp[4 * ATT_VS] = (bf16_t)(vv.z & 0xffff); vp[5 * ATT_VS] = (bf16_t)(vv.z >> 16); vp[6 * ATT_VS] = (bf16_t)(vv.w & 0xffff); vp[7 * ATT_VS] = (bf16_t)(vv.w >> 16); }
    __syncthreads();
    const int fr = lane & 15, fq = lane >> 4, w = wave;
    const size_t tq = (size_t)r + (size_t)dil * (128 * n + 16 * w + fr);
    bf16x8 qf[4];
#pragma unroll
    for (int ks = 0; ks < 4; ++ks) qf[ks] = *(const bf16x8*)(H + tq * NH + O_Q + head * 128 + ks * 32 + fq * 8);
    f32x4 st[9];
#pragma unroll
    for (int kk = 0; kk < 9; ++kk) { st[kk] = (f32x4){0.f, 0.f, 0.f, 0.f}; const int kt = w + kk;
#pragma unroll
        for (int ks = 0; ks < 4; ++ks) { const bf16x8 kf = *(const LAS bf16x8*)(Ks + (16 * kt + fr) * ATT_KS + ks * 32 + fq * 8);
            st[kk] = __builtin_amdgcn_mfma_f32_16x16x32_bf16(kf, qf[ks], st[kk], 0, 0, 0); } }
    const float scale = 0.08838834764831845f; float mx = -1e30f;
    const int xo = 4 * fq - fr; const LAS float* bp = biasL + (16 + 128 - xo - 131);
#pragma unroll
    for (int kk = 0; kk < 9; ++kk) { const bool tile_ok = !(n == 0 && (w + kk) < 8);
#pragma unroll
        for (int e = 0; e < 4; ++e) { bool valid = tile_ok; if (kk == 0) valid = valid && (e + xo >= 0); if (kk == 8) valid = valid && (e + xo <= 0);
            const float lg = valid ? st[kk][e] * scale + bp[131 - (16 * kk + e)] : -1e30f; st[kk][e] = lg; mx = fmaxf(mx, lg); } }
    mx = fmaxf(mx, __shfl_xor(mx, 16)); mx = fmaxf(mx, __shfl_xor(mx, 32));
    float den = 0.f;
#pragma unroll
    for (int kk = 0; kk < 9; ++kk)
#pragma unroll
        for (int e = 0; e < 4; ++e) { const float p = __expf(st[kk][e] - mx); st[kk][e] = p; den += p; }
    den += __shfl_xor(den, 16); den += __shfl_xor(den, 32);
    f32x4 ot[8];
#pragma unroll
    for (int dt = 0; dt < 8; ++dt) ot[dt] = (f32x4){0.f, 0.f, 0.f, 0.f};
#pragma unroll
    for (int s = 0; s < 5; ++s) { const int kk0 = 2 * s, kk1 = 2 * s + 1;
        u32x4 pw; pw.x = pk2(st[kk0][0], st[kk0][1]); pw.y = pk2(st[kk0][2], st[kk0][3]);
        if (kk1 < 9) { pw.z = pk2(st[kk1 < 9 ? kk1 : 8][0], st[kk1 < 9 ? kk1 : 8][1]); pw.w = pk2(st[kk1 < 9 ? kk1 : 8][2], st[kk1 < 9 ? kk1 : 8][3]); } else { pw.z = 0u; pw.w = 0u; }
        const bf16x8 pb = __builtin_bit_cast(bf16x8, pw);
        const int kt0 = w + kk0; int kt1 = w + kk1; kt1 = kt1 > 15 ? 15 : kt1;
#pragma unroll
        for (int dt = 0; dt < 8; ++dt) { const LAS bf16_t* vr = Vt + (16 * dt + fr) * ATT_VS + 4 * fq;
            const u32x2 lo = *(const LAS u32x2*)(vr + 16 * kt0), hi = *(const LAS u32x2*)(vr + 16 * kt1);
            const u32x4 va = (u32x4){lo.x, lo.y, hi.x, hi.y};
            ot[dt] = __builtin_amdgcn_mfma_f32_16x16x32_bf16(__builtin_bit_cast(bf16x8, va), pb, ot[dt], 0, 0, 0); } }
    const float rden = 1.f / den;
    float* OG = (float*)(ws + WS_OG) + (size_t)g * SEQ * BW + tq * BW + hh * 128 + 4 * fq;
#pragma unroll
    for (int dt = 0; dt < 8; ++dt) *(f32x4*)(OG + 16 * dt) = ot[dt] * rden;
    if (fq == 0) { ((float*)(ws + WS_MG))[((size_t)g * SEQ + tq) * 4 + hh] = mx; ((float*)(ws + WS_DG))[((size_t)g * SEQ + tq) * 4 + hh] = den; }
    __syncthreads();
}
__device__ __forceinline__ void att_merge_unit(int unit, int tid) {
    unsigned char* ws = ws_ptr(); const bf16_t* H = (const bf16_t*)(ws + WS_H); bf16_t* YSG = (bf16_t*)(ws + WS_YSG);
    const float* OG = (const float*)(ws + WS_OG); const float* MG = (const float*)(ws + WS_MG); const float* DG = (const float*)(ws + WS_DG);
    const size_t t = (size_t)unit * 16 + (tid >> 5); const int c0 = (tid & 31) * 16, hh = c0 >> 7;
    float m[3], d[3];
#pragma unroll
    for (int g = 0; g < 3; ++g) { m[g] = MG[((size_t)g * SEQ + t) * 4 + hh]; d[g] = DG[((size_t)g * SEQ + t) * 4 + hh]; }
    const float mm = fmaxf(m[0], fmaxf(m[1], m[2]));
    float wt[3], ws_ = 0.f;
#pragma unroll
    for (int g = 0; g < 3; ++g) { wt[g] = __expf(m[g] - mm) * d[g]; ws_ += wt[g]; }
    const float inv = 1.f / ws_;
#pragma unroll
    for (int q = 0; q < 4; ++q) { f32x4 acc = (f32x4){0.f, 0.f, 0.f, 0.f};
#pragma unroll
        for (int g = 0; g < 3; ++g) acc += *(const f32x4*)(OG + ((size_t)g * SEQ + t) * BW + c0 + 4 * q) * wt[g];
        const u32x2 gw = *(const u32x2*)(H + t * NH + O_BG + c0 + 4 * q);
        u32x2 o; o.x = pk2(acc[0] * inv * silu(wlo(gw.x)), acc[1] * inv * silu(whi(gw.x))); o.y = pk2(acc[2] * inv * silu(wlo(gw.y)), acc[3] * inv * silu(whi(gw.y)));
        *(u32x2*)(YSG + t * DM + BW + c0 + 4 * q) = o; }
}

__device__ __forceinline__ void ln_row(const float* z, const float* g, const float* b, float* of, bf16_t* ob, int lane) {
    f32x4 v[8]; float s = 0.f;
#pragma unroll
    for (int j = 0; j < 8; ++j) { v[j] = *(const f32x4*)(z + 4 * lane + 256 * j); s += (v[j][0] + v[j][1]) + (v[j][2] + v[j][3]); }
    const float mean = wave_sum(s) * (1.f / DM); float s2 = 0.f;
#pragma unroll
    for (int j = 0; j < 8; ++j) { v[j] = v[j] - mean; s2 += (v[j][0] * v[j][0] + v[j][1] * v[j][1]) + (v[j][2] * v[j][2] + v[j][3] * v[j][3]); }
    const float rstd = rsqrtf(wave_sum(s2) * (1.f / DM) + LN_EPS);
#pragma unroll
    for (int j = 0; j < 8; ++j) { const int c = 4 * lane + 256 * j; const f32x4 gg = *(const f32x4*)(g + c), bb = *(const f32x4*)(b + c);
        const f32x4 o = v[j] * rstd * gg + bb; *(f32x4*)(of + c) = o;
        if (ob) { u32x2 w; w.x = pk2(o[0], o[1]); w.y = pk2(o[2], o[3]); *(u32x2*)(ob + c) = w; } }
}

constexpr int NPL = 7, NPHASE = 1 + DEPTH * NPL;
__global__ void __launch_bounds__(NTHREADS, 2) hybrid_fwd(Args args) {
    extern __shared__ __attribute__((aligned(16))) unsigned char lds_raw[];
    LAS unsigned char* lds = (LAS unsigned char*)lds_raw;
    const int tid0 = threadIdx.x;
    const int G = gridDim.x; const int bx0 = blockIdx.x;
    volatile LAS unsigned* MISC = (volatile LAS unsigned*)(lds + MISC_OFF);
    for (int u = tid0; u < (LDS_BYTES - RING_BYTES) / 4; u += NTHREADS) ((LAS unsigned*)(lds + RING_BYTES))[u] = 0u;
    __syncthreads();
    XcdBarrier bar; bar.bar = (unsigned*)(ws_ptr() + WS_CTL) + 4096; bar.x = 0; bar.st = nullptr;
    const bool multi = (args.ph_hi - args.ph_lo) > 1;
    if (multi) bar = xcd_barrier_post((unsigned*)(ws_ptr() + WS_CTL) + 4096, MISC + 8);

    for (int ph = args.ph_lo; ph < args.ph_hi; ++ph) {
        int tid = tid0, bx = bx0; asm volatile("" : "+v"(tid)); asm volatile("" : "+s"(bx));
        const int lane = tid & 63, wave = __builtin_amdgcn_readfirstlane(tid >> 6);
        const int vcu = (G % 8 == 0) ? (bx % 8) * (G / 8) + bx / 8 : bx;
        unsigned char* ws = ws_ptr();
        if (ph == 0) {

#if PH_MASK & 1
            p0_prologue(lds, vcu, G, wave, lane, tid);
#endif

        } else {
            const int l = (ph - 1) / NPL, sp = (ph - 1) % NPL;
            if (sp == 0) {
                pg8::Gemm g{(const bf16_t*)(ws + WS_XB), (const bf16_t*)(ws + WS_WIN + l * SZ_WIN), SEQ, NPAD, DM, DM, DM};
                pg8::StaticOrder S; S.init(SEQ, NPAD, G, bx);
                pg8::EpiIn E{(bf16_t*)(ws + WS_H), (bf16_t*)(ws + WS_G), (const float*)(ws + WS_BIN) + l * NPAD};

#if PH_MASK & 2
                pg8::gemm_phase<pg8::EpiIn, pg8::StaticOrder, true>(lds, g, S, E, tid);
#endif

            } else if (sp == 1) {

#if PH_MASK & 4
                for (int u = vcu; u < 256; u += G) lru_pre_unit(l, u, lds, tid);
#endif


#if PH_MASK & 8
                for (int u = vcu; u < 512; u += G) conf_unit(l, u, lds, tid, wave, lane);
#endif


#if PH_MASK & 16
                for (int u = vcu; u < 256; u += G) rwkv_prep_unit(l, u, lds, tid);
#endif


#if PH_MASK & 32
                for (int u = vcu; u < 768; u += G) att_unit(u, lds, tid, wave, lane);
#endif

            } else if (sp == 2) {

#if PH_MASK & 64
                if (vcu == G - 1) lru_carry(tid);
#endif


#if PH_MASK & 128
                if (vcu < 64) rwkv_scan_unit(vcu, lds, tid, wave, lane); else
#endif
                for (int u = vcu - 64; u < 512; u += G - 64) att_merge_unit(u, tid);
            } else if (sp == 3) {
                for (int u = vcu; u < 256; u += G) lru_post_unit(u, tid);

#if PH_MASK & 256
                for (int u = vcu; u < 256; u += G) rwkv_post_unit(l, u, lds, tid, wave, lane);
#endif

            } else if (sp == 4) {
                pg8::StaticOrder S; S.init(SEQ, DM, G, bx);
                const bf16_t* Gm = (const bf16_t*)(ws + WS_G); float* MIXF = (float*)(ws + WS_MIXF); bf16_t* MIX = (bf16_t*)(ws + WS_MIX);
                const bf16_t* Ab = (const bf16_t*)(ws + WS_YSG); const bf16_t* Bb = (const bf16_t*)(ws + WS_WBR + l * SZ_W2);
                { pg8::Gemm g{Ab, Bb, SEQ, DM, BW, DM, DM}; pg8::EpiMix<0> E{Gm, 0, MIXF, MIX};
#if PH_MASK & 512
pg8::gemm_phase<pg8::EpiMix<0>, pg8::StaticOrder, true>(lds, g, S, E, tid);
#endif
 }
                { pg8::Gemm g{Ab + BW, Bb + BW, SEQ, DM, BW, DM, DM}; pg8::EpiMix<1> E{Gm, DM, MIXF, MIX};
#if PH_MASK & 512
pg8::gemm_phase<pg8::EpiMix<1>, pg8::StaticOrder, true>(lds, g, S, E, tid);
#endif
 }
                { pg8::Gemm g{Ab + 2 * BW, Bb + 2 * BW, SEQ, DM, BW, DM, DM}; pg8::EpiMix<1> E{Gm, 2 * DM, MIXF, MIX};
#if PH_MASK & 512
pg8::gemm_phase<pg8::EpiMix<1>, pg8::StaticOrder, true>(lds, g, S, E, tid);
#endif
 }
                { pg8::Gemm g{Ab + 3 * BW, Bb + 3 * BW, SEQ, DM, BW, DM, DM}; pg8::EpiMix<2> E{Gm, 3 * DM, MIXF, MIX};
#if PH_MASK & 512
pg8::gemm_phase<pg8::EpiMix<2>, pg8::StaticOrder, true>(lds, g, S, E, tid);
#endif
 }
            } else if (sp == 5) {
                pg8::Gemm g{(const bf16_t*)(ws + WS_MIX), (const bf16_t*)(ws + WS_WOUT + l * SZ_W2), SEQ, DM, DM, DM, DM};
                pg8::StaticOrder S; S.init(SEQ, DM, G, bx);
                pg8::EpiOut E{l == 0 ? in_ptr<0>() : (const float*)(ws + WS_XF), (float*)(ws + WS_Z)};

#if PH_MASK & 1024
                pg8::gemm_phase<pg8::EpiOut, pg8::StaticOrder, true>(lds, g, S, E, tid);
#endif

            } else {
                const float* Z = (const float*)(ws + WS_Z); const float* lg = in_ptr<27>() + l * DM; const float* lb = in_ptr<28>() + l * DM;
                float* of = l == DEPTH - 1 ? out_ptr() : (float*)(ws + WS_XF); bf16_t* ob = l == DEPTH - 1 ? nullptr : (bf16_t*)(ws + WS_XB);
                for (int row = vcu * NWAVES + wave; row < SEQ; row += G * NWAVES) ln_row(Z + (size_t)row * DM, lg, lb, of + (size_t)row * DM, ob ? ob + (size_t)row * DM : nullptr, lane);
            }
        }
        if (ph + 1 < args.ph_hi) xcd_barrier(bar);
    }
}

extern "C" void kernel_launch(void* const* d_in, const int* in_sizes, int n_in, void* d_out, int out_size, void* d_ws, size_t ws_size, hipStream_t stream) {
    static int grid = 0;
    if (grid == 0) {
        if (n_in != 29 || out_size != SEQ * DM || ws_size < WS_END) { fprintf(stderr, "kernel_launch: unexpected shapes (n_in %d, out %d, ws %zu, need %zu)\n", n_in, out_size, ws_size, (size_t)WS_END); grid = -1; return; }
        int dev = 0, cus = 0;
        if (hipGetDevice(&dev) != hipSuccess || hipDeviceGetAttribute(&cus, hipDeviceAttributeMultiprocessorCount, dev) != hipSuccess) { grid = -1; return; }
        if (hipFuncSetAttribute((const void*)hybrid_fwd, hipFuncAttributeMaxDynamicSharedMemorySize, LDS_BYTES) != hipSuccess) { fprintf(stderr, "kernel_launch: hipFuncSetAttribute failed\n"); grid = -1; return; }
        int per_cu = 0;
        if (hipOccupancyMaxActiveBlocksPerMultiprocessor(&per_cu, (const void*)hybrid_fwd, NTHREADS, LDS_BYTES) != hipSuccess || per_cu < 1) fprintf(stderr, "kernel_launch: occupancy query reports %d\n", per_cu);
        (void)hipGetLastError();
        grid = cus;
    }
    if (grid < 0) return;
    (void)hipMemsetAsync((char*)d_ws + WS_CTL, 0, CTL_ZERO_BYTES, stream);
    Args a{};
    for (int i = 0; i < 29; ++i) a.in[i] = (const float*)d_in[i];
    a.out = (float*)d_out; a.ws = (unsigned char*)d_ws;
#if MK_ONE_LAUNCH
    a.ph_lo = 0; a.ph_hi = NPHASE;
    hipLaunchKernelGGL(hybrid_fwd, dim3(grid), dim3(NTHREADS), LDS_BYTES, stream, a);
#else
    for (int ph = 0; ph < NPHASE; ++ph) { a.ph_lo = ph; a.ph_hi = ph + 1; hipLaunchKernelGGL(hybrid_fwd, dim3(grid), dim3(NTHREADS), LDS_BYTES, stream, a); }
#endif
}
```

```cpp
#include <hip/hip_runtime.h>
#include <cstdio>
#include <cstdint>

#ifndef MK_ONE_LAUNCH
#define MK_ONE_LAUNCH 1
#endif
#ifndef RPT_SEL
#define RPT_SEL -1
#endif
#define LAS __attribute__((address_space(3)))
#define GAS __attribute__((address_space(1)))
typedef unsigned short bf16_t;
typedef short bf16x8 __attribute__((ext_vector_type(8)));
typedef float f32x4 __attribute__((ext_vector_type(4)));
typedef float f32x2 __attribute__((ext_vector_type(2)));
typedef unsigned u32x4 __attribute__((ext_vector_type(4)));
typedef unsigned u32x2 __attribute__((ext_vector_type(2)));

constexpr int SEQ = 8192, DM = 2048, DEPTH = 2, BW = 512, D_IN = 18048;
constexpr int NSPLIT = 9856;
constexpr int NH = 9984;
constexpr int NPAD = NH + 8192;
constexpr int NT_H = NH / 256;
constexpr int O_AX = 0, O_AG = 512, O_Q = 1024, O_K = 2560, O_V = 4096, O_BG = 5632, O_CR = 6144, O_CK = 6656, O_CV = 7168, O_CWD = 7680,
              O_CAD = 7744, O_CG = 7808, O_DV = 8320, O_DGLU = 8832, O_DG = 9344;
constexpr float ALPHA = 1.41421356237309515f;
constexpr float LN_EPS = 1e-5f, GN_EPS = 64e-5f;

__device__ __forceinline__ float bf2f(unsigned b) { return __uint_as_float(b << 16); }
__device__ __forceinline__ unsigned f2bf(float f) { unsigned u = __float_as_uint(f); return (u + 0x7fffu + ((u >> 16) & 1u)) >> 16; }
__device__ __forceinline__ unsigned pk2(float lo, float hi) { return f2bf(lo) | (f2bf(hi) << 16); }
__device__ __forceinline__ float wlo(unsigned w) { return __uint_as_float(w << 16); }
__device__ __forceinline__ float whi(unsigned w) { return __uint_as_float(w & 0xffff0000u); }
__device__ __forceinline__ float sigm(float x) { return 1.f / (1.f + __expf(-x)); }
__device__ __forceinline__ float silu(float x) { return x / (1.f + __expf(-x)); }
__device__ __forceinline__ float softplusf(float y) { return fmaxf(y, 0.f) + log1pf(__expf(-fabsf(y))); }
__device__ __forceinline__ float wave_sum(float v) {
#pragma unroll
    for (int o = 1; o < 64; o <<= 1) v += __shfl_xor(v, o);
    return v;
}

namespace pg8 {
constexpr int BM = 256, BK = 64, HALF = 128, HTB = HALF * BK * 2, STAGE_BYTES = 8 * HTB, NXCD = 8, WGM = 8;
__host__ __device__ __forceinline__ int lds_byte(int r, int c) { const int st = (r >> 4) * 2 + (c >> 5), rr = r & 15, cc = c & 31, ob = rr * 64 + cc * 2; return st * 1024 + (ob ^ (((ob >> 9) & 1) << 5)); }
__host__ __device__ __forceinline__ void stage_rc(int b, int& R, int& C) { const int st = b / 1024, sb = b % 1024, swz = sb ^ (((sb >> 9) & 1) << 5); R = (st >> 1) * 16 + swz / 64; C = (st & 1) * 32 + (swz % 64) / 2; }
__host__ __device__ __forceinline__ int perm32(int rho) { const int n = rho >> 4, i = rho & 15; return 8 * (i >> 2) + 4 * n + (i & 3); }

struct Unit { int pm, pn; };
struct Gemm { const bf16_t* A; const bf16_t* Bt; int M, N, K, lda, ldb; };

struct StaticOrder {
    int nM, nN, nwg, G, c;
    __device__ void init(int M, int N, int G_, int c_) { nM = M / BM; nN = N / BM; nwg = nM * nN; G = G_; c = c_; }
    __device__ bool next(int i, Unit& u) const {
        const long L = (long)i * G + c; if (L >= nwg) return false;
        int wgid = (int)L; { const int q = nwg / NXCD, r = nwg % NXCD, xcd = wgid % NXCD, off = wgid / NXCD; wgid = (xcd < r ? xcd * (q + 1) : r * (q + 1) + (xcd - r) * q) + off; }
        const int nig = WGM * nN, gid = wgid / nig, fm = gid * WGM, gsz = (nM - fm) < WGM ? (nM - fm) : WGM;
        u.pm = fm + ((wgid % nig) % gsz); u.pn = (wgid % nig) / gsz; return true;
    }
};

__device__ __forceinline__ unsigned cvt_pk_bf16(float lo, float hi) { unsigned r; asm volatile("v_cvt_pk_bf16_f32 %0, %1, %2" : "=v"(r) : "v"(lo), "v"(hi)); return r; }


struct EpiIn {
    static constexpr bool PERM = true;
    bf16_t* H; bf16_t* G; const float* bias;
    __device__ __forceinline__ void operator()(const f32x4 (&acc)[2][2][4][2], const Unit& u, int wr, int wc, int fr, int fq) const {
        const int row0 = u.pm * BM + wr * 64 + fr, bcol0 = u.pn * BM + wc * 32 + 8 * fq;
        const bool isg = u.pn >= NT_H;
        bf16_t* base = isg ? G : H; const int ldc = isg ? 8192 : NH; const int col0 = isg ? bcol0 - NH : bcol0;
        f32x4 bv[2][2];
#pragma unroll
        for (int bj = 0; bj < 2; ++bj)
#pragma unroll
            for (int n = 0; n < 2; ++n) bv[bj][n] = *(const f32x4*)(bias + bcol0 + bj * HALF + 4 * n);
#pragma unroll
        for (int ai = 0; ai < 2; ++ai)
#pragma unroll
            for (int m = 0; m < 4; ++m) { bf16_t* rowp = base + (size_t)(row0 + ai * HALF + m * 16) * ldc + col0;
#pragma unroll
                for (int bj = 0; bj < 2; ++bj) { f32x4 v0 = acc[ai][bj][m][0] + bv[bj][0], v1 = acc[ai][bj][m][1] + bv[bj][1];
                    if (isg) {
#pragma unroll
                        for (int e = 0; e < 4; ++e) { v0[e] = __builtin_amdgcn_rcpf(1.f + __expf(-v0[e])); v1[e] = __builtin_amdgcn_rcpf(1.f + __expf(-v1[e])); } }
                    u32x4 w; w.x = cvt_pk_bf16(v0[0], v0[1]); w.y = cvt_pk_bf16(v0[2], v0[3]); w.z = cvt_pk_bf16(v1[0], v1[1]); w.w = cvt_pk_bf16(v1[2], v1[3]);
                    *(u32x4*)(rowp + bj * HALF) = w; } }
    }
};
template <int MODE> struct EpiMix {
    static constexpr bool PERM = true;
    const bf16_t* G; int gcol; float* MIXF; bf16_t* MIX;
    __device__ __forceinline__ void operator()(const f32x4 (&acc)[2][2][4][2], const Unit& u, int wr, int wc, int fr, int fq) const {
        const int row0 = u.pm * BM + wr * 64 + fr, col0 = u.pn * BM + wc * 32 + 8 * fq;
#pragma unroll
        for (int ai = 0; ai < 2; ++ai)
#pragma unroll
            for (int m = 0; m < 4; ++m) { const size_t row = (size_t)(row0 + ai * HALF + m * 16);
#pragma unroll
                for (int bj = 0; bj < 2; ++bj) { const int c = col0 + bj * HALF;
                    const u32x4 gv = *(const u32x4*)(G + row * 8192 + gcol + c);
                    f32x4 v0 = acc[ai][bj][m][0], v1 = acc[ai][bj][m][1];
                    v0[0] *= wlo(gv.x); v0[1] *= whi(gv.x); v0[2] *= wlo(gv.y); v0[3] *= whi(gv.y);
                    v1[0] *= wlo(gv.z); v1[1] *= whi(gv.z); v1[2] *= wlo(gv.w); v1[3] *= whi(gv.w);
                    float* mp = MIXF + row * DM + c;
                    if (MODE >= 1) { v0 += *(const f32x4*)mp; v1 += *(const f32x4*)(mp + 4); }
                    if (MODE <= 1) { *(f32x4*)mp = v0; *(f32x4*)(mp + 4) = v1; }
                    else { u32x4 w; w.x = cvt_pk_bf16(v0[0], v0[1]); w.y = cvt_pk_bf16(v0[2], v0[3]); w.z = cvt_pk_bf16(v1[0], v1[1]); w.w = cvt_pk_bf16(v1[2], v1[3]);
                        *(u32x4*)(MIX + row * DM + c) = w; } }
                asm volatile("" ::: "memory"); }
    }
};
struct EpiOut {
    static constexpr bool PERM = true;
    const float* xres; float* Z;
    __device__ __forceinline__ void operator()(const f32x4 (&acc)[2][2][4][2], const Unit& u, int wr, int wc, int fr, int fq) const {
        const int row0 = u.pm * BM + wr * 64 + fr, col0 = u.pn * BM + wc * 32 + 8 * fq;
#pragma unroll
        for (int ai = 0; ai < 2; ++ai)
#pragma unroll
            for (int m = 0; m < 4; ++m) { const size_t row = (size_t)(row0 + ai * HALF + m * 16);
#pragma unroll
                for (int bj = 0; bj < 2; ++bj) { const size_t off = row * DM + col0 + bj * HALF;
                    const f32x4 x0 = *(const f32x4*)(xres + off), x1 = *(const f32x4*)(xres + off + 4);
                    *(f32x4*)(Z + off) = x0 * ALPHA + acc[ai][bj][m][0]; *(f32x4*)(Z + off + 4) = x1 * ALPHA + acc[ai][bj][m][1]; }
                asm volatile("" ::: "memory"); }
    }
};

template <class Epi, class Sched, bool ALIGN_EPI>
__device__ __forceinline__ void gemm_phase(LAS unsigned char* lds, const Gemm g, const Sched& S, const Epi& E, const int tid) {
    const int wid = __builtin_amdgcn_readfirstlane(tid >> 6), lane = tid & 63, wr = wid >> 2, wc = wid & 3, fr = lane & 15, fq = lane >> 4;
    const int K = g.K, nt = K / BK;
    unsigned voffA[2], voffB[2];
#pragma unroll
    for (int i = 0; i < 2; ++i) { int R, C; stage_rc(tid * 16 + i * 8192, R, C); const int Rb = Epi::PERM ? ((R & ~31) + perm32(R & 31)) : R;
        voffA[i] = (unsigned)(R * g.lda + C) * 2u; voffB[i] = (unsigned)(Rb * g.ldb + C) * 2u; }
    const size_t kstep = (size_t)(BK * 2);
    const size_t hstepA = (size_t)HALF * g.lda * 2, hstepB = (size_t)HALF * g.ldb * 2;
    const size_t tstepA = 2 * hstepA, tstepB = 2 * hstepB;
    const unsigned ldsw = (unsigned)wid * 1024u;
    const int aoff = lds_byte(wr * 64 + fr, fq * 8), boff = lds_byte(wc * 32 + fr, fq * 8);
#define PG8_SA(b, h) (((b) * 2 + (h)) * HTB)
#define PG8_SB(b, h) ((4 + (b) * 2 + (h)) * HTB)
#define PG8_STAGE(bufoff, gbase, voff) do { _Pragma("unroll") for (int _i = 0; _i < 2; ++_i) \
        __builtin_amdgcn_global_load_lds((const unsigned*)((const char*)(gbase) + (voff)[_i]), (LAS unsigned*)(lds + (bufoff) + ldsw + _i * 8192), 16, 0, 0); } while (0)
#define PG8_LDA(dst, b, h) do { _Pragma("unroll") for (int m = 0; m < 4; ++m) _Pragma("unroll") for (int k = 0; k < 2; ++k) dst[m][k] = *(const LAS bf16x8*)(lds + PG8_SA(b, h) + aoff + m * 2048 + k * 1024); } while (0)
#define PG8_LDB(dst, b, h) do { _Pragma("unroll") for (int n = 0; n < 2; ++n) _Pragma("unroll") for (int k = 0; k < 2; ++k) dst[n][k] = *(const LAS bf16x8*)(lds + PG8_SB(b, h) + boff + n * 2048 + k * 1024); } while (0)
#define PG8_MMA(ai, bj, At, Bt) do { __builtin_amdgcn_s_setprio(1); _Pragma("unroll") for (int m = 0; m < 4; ++m) _Pragma("unroll") for (int n = 0; n < 2; ++n) _Pragma("unroll") for (int k = 0; k < 2; ++k) \
        acc[ai][bj][m][n] = __builtin_amdgcn_mfma_f32_16x16x32_bf16(Bt[n][k], At[m][k], acc[ai][bj][m][n], 0, 0, 0); __builtin_amdgcn_s_setprio(0); } while (0)
#define PG8_WAIT_V(n) asm volatile("s_waitcnt vmcnt(" #n ")" ::: "memory")
#define PG8_WAIT_L(n) asm volatile("s_waitcnt lgkmcnt(" #n ")" ::: "memory")
#define PG8_BAR __builtin_amdgcn_s_barrier()
#define PG8_SCHED __builtin_amdgcn_sched_barrier(0)
    Unit cur, nxt; int ui = 0;
    if (!S.next(0, cur)) return;
    f32x4 acc[2][2][4][2];
#pragma unroll
    for (int a = 0; a < 2; ++a)
#pragma unroll
        for (int b = 0; b < 2; ++b)
#pragma unroll
            for (int m = 0; m < 4; ++m)
#pragma unroll
                for (int n = 0; n < 2; ++n) { float z_ = 0.f; asm volatile("" : "+v"(z_)); acc[a][b][m][n] = (f32x4){z_, z_, z_, z_}; }
    bf16x8 At[4][2], B0[2][2], B1[2][2];
    const char* cA = (const char*)g.A + (size_t)cur.pm * tstepA; const char* cB = (const char*)g.Bt + (size_t)cur.pn * tstepB;
    PG8_STAGE(PG8_SB(0, 0), cB, voffB); PG8_STAGE(PG8_SB(0, 1), cB + hstepB, voffB); PG8_STAGE(PG8_SA(0, 0), cA, voffA); PG8_STAGE(PG8_SA(0, 1), cA + hstepA, voffA);
    if (wr == 1) PG8_BAR;
    PG8_WAIT_V(2); PG8_BAR;
    PG8_STAGE(PG8_SB(1, 0), cB + kstep, voffB); PG8_STAGE(PG8_SA(1, 0), cA + kstep, voffA); PG8_STAGE(PG8_SB(1, 1), cB + hstepB + kstep, voffB);
    PG8_WAIT_V(6); PG8_BAR;
    for (;;) {
        const bool has_next = S.next(ui + 1, nxt);
        const char* nA = has_next ? (const char*)g.A + (size_t)nxt.pm * tstepA : cA; const char* nB = has_next ? (const char*)g.Bt + (size_t)nxt.pn * tstepB : cB;
        for (int t = 0; t < nt; t += 2) {
            const bool last = (t == nt - 2);
            const char* a1 = cA + (size_t)(t + 1) * kstep;
            const char* a2 = last ? nA : cA + (size_t)(t + 2) * kstep; const char* b2 = last ? nB : cB + (size_t)(t + 2) * kstep;
            const char* a3 = a2 + kstep; const char* b3 = b2 + kstep;
            PG8_LDB(B0, 0, 0); PG8_LDB(B1, 0, 1); PG8_SCHED; PG8_LDA(At, 0, 0); PG8_STAGE(PG8_SA(1, 1), a1 + hstepA, voffA);
            PG8_WAIT_V(8); PG8_WAIT_L(0); PG8_BAR; PG8_MMA(0, 0, At, B0); PG8_MMA(0, 1, At, B1); PG8_BAR; PG8_SCHED;
            PG8_LDA(At, 0, 1); PG8_STAGE(PG8_SB(0, 0), b2, voffB); PG8_STAGE(PG8_SB(0, 1), b2 + hstepB, voffB); PG8_STAGE(PG8_SA(0, 0), a2, voffA);
            PG8_WAIT_V(8); PG8_WAIT_L(0); PG8_BAR; PG8_MMA(1, 0, At, B0); PG8_MMA(1, 1, At, B1); PG8_BAR; PG8_SCHED;
            PG8_LDB(B0, 1, 0); PG8_LDB(B1, 1, 1); PG8_SCHED; PG8_LDA(At, 1, 0); PG8_STAGE(PG8_SA(0, 1), a2 + hstepA, voffA);
            PG8_WAIT_V(8); PG8_WAIT_L(0); PG8_BAR; PG8_MMA(0, 0, At, B0); PG8_MMA(0, 1, At, B1); PG8_BAR; PG8_SCHED;
            PG8_LDA(At, 1, 1); PG8_STAGE(PG8_SB(1, 0), b3, voffB); PG8_STAGE(PG8_SB(1, 1), b3 + hstepB, voffB); PG8_STAGE(PG8_SA(1, 0), a3, voffA);
            PG8_WAIT_V(8); PG8_WAIT_L(0); PG8_BAR; PG8_MMA(1, 0, At, B0); PG8_MMA(1, 1, At, B1); PG8_BAR; PG8_SCHED;
        }
        if constexpr (ALIGN_EPI) { if (wr == 0) PG8_BAR; }
        E(acc, cur, wr, wc, fr, fq);
        if (!has_next) break;
#pragma unroll
        for (int a = 0; a < 2; ++a)
#pragma unroll
            for (int b = 0; b < 2; ++b)
#pragma unroll
                for (int m = 0; m < 4; ++m)
#pragma unroll
                    for (int n = 0; n < 2; ++n) acc[a][b][m][n] = (f32x4){0.f, 0.f, 0.f, 0.f};
        cur = nxt; cA = nA; cB = nB; ++ui;
        if constexpr (ALIGN_EPI) { if (wr == 1) PG8_BAR; }
    }
    PG8_WAIT_V(0);
    if constexpr (!ALIGN_EPI) { if (wr == 0) PG8_BAR; }
    PG8_BAR;
#undef PG8_SA
#undef PG8_SB
#undef PG8_STAGE
#undef PG8_LDA
#undef PG8_LDB
#undef PG8_MMA
#undef PG8_WAIT_V
#undef PG8_WAIT_L
#undef PG8_BAR
#undef PG8_SCHED
}
}

constexpr size_t MiB = 1u << 20;
constexpr size_t al256(size_t x) { return (x + 255) & ~(size_t)255; }
constexpr size_t WS_CTL = 0, CTL_ZERO_BYTES = 1 * MiB;
constexpr size_t SZ_WIN = (size_t)NPAD * DM * 2, SZ_W2 = (size_t)DM * DM * 2, SZ_ACT_F32 = (size_t)SEQ * DM * 4, SZ_ACT_BF = (size_t)SEQ * DM * 2, SZ_BR_F32 = (size_t)SEQ * BW * 4;
constexpr size_t WS_WIN = 1 * MiB;
constexpr size_t WS_WBR = WS_WIN + 2 * SZ_WIN;
constexpr size_t WS_WOUT = WS_WBR + 2 * SZ_W2;
constexpr size_t WS_BIN = WS_WOUT + 2 * SZ_W2;
constexpr size_t WS_XB = al256(WS_BIN + 2 * (size_t)NPAD * 4);
constexpr size_t WS_XF = WS_XB + SZ_ACT_BF;
constexpr size_t WS_H = WS_XF + SZ_ACT_F32;
constexpr size_t WS_MIXF = WS_H;
constexpr size_t WS_Z = WS_H + SZ_ACT_F32;
constexpr size_t WS_G = WS_H + (size_t)SEQ * NH * 2;
constexpr size_t WS_YSG = WS_G + (size_t)SEQ * 8192 * 2;
constexpr size_t WS_MIX = WS_YSG + SZ_ACT_BF;
constexpr size_t WS_OG = WS_MIX + SZ_ACT_BF;
constexpr size_t WS_MG = WS_OG + 3 * SZ_BR_F32;
constexpr size_t WS_DG = WS_MG + 3 * (size_t)SEQ * 4 * 4;
constexpr size_t WS_HL = WS_DG + 3 * (size_t)SEQ * 4 * 4;
constexpr size_t WS_CA = WS_HL + SZ_BR_F32;
constexpr size_t WS_SA = WS_CA + SZ_BR_F32;
constexpr size_t WS_SH = WS_SA + 256 * 512 * 4;
constexpr size_t WS_CARRY = WS_SH + 256 * 512 * 4;
constexpr size_t WS_RR = WS_CARRY + 256 * 512 * 4;
constexpr size_t WS_WY = WS_RR + 7 * SZ_BR_F32;
constexpr size_t SZ_UM = (size_t)1024 * 64 * 64 * 4;
constexpr size_t WS_GAMT = WS_WY + SZ_BR_F32;
constexpr size_t WS_ZT = WS_GAMT + SZ_UM;
constexpr size_t WS_RH = WS_ZT + SZ_UM;
constexpr size_t WS_WH = WS_RH + SZ_UM;
constexpr size_t WS_SST = WS_WH + SZ_UM;
constexpr size_t WS_END = WS_SST + SZ_UM;
static_assert(WS_Z + SZ_ACT_F32 <= WS_G, "MIXF and Z overlay H");

constexpr int RING_BYTES = 143360;
constexpr int MISC_OFF = RING_BYTES + 320;
constexpr int LDS_BYTES = 151552;
constexpr int NWAVES = 8, NTHREADS = 512;

template <int OFF> __device__ __forceinline__ unsigned long long karg64() {
    auto kp = __builtin_amdgcn_kernarg_segment_ptr(); unsigned long long p;
    asm volatile("s_load_dwordx2 %0, %1, %2\n\ts_waitcnt lgkmcnt(0)" : "=s"(p) : "s"(kp), "i"(OFF) : "memory");
    return p;
}
template <int I> __device__ __forceinline__ const float* in_ptr() { return (const float*)karg64<8 * I>(); }
__device__ __forceinline__ float* out_ptr() { return (float*)karg64<232>(); }
__device__ __forceinline__ unsigned char* ws_ptr() { return (unsigned char*)karg64<240>(); }
#define XB_TMO      128
#define XB_XCNT(j)  (256  + 64 * (j))
#define XB_XSUB(j)  (1280 + 64 * (j))
#define XB_XGEN(j)  (2304 + 64 * (j))
#define XB_TOP      3328
#define XB_TOPGEN   3392
#define XCD_BAR_WORDS 3456
#define XB_SPIN_CAP (1u << 18)
__device__ __forceinline__ unsigned xb_ld(unsigned* p)              { return __hip_atomic_load(p, __ATOMIC_RELAXED, __HIP_MEMORY_SCOPE_AGENT); }
__device__ __forceinline__ unsigned xb_add(unsigned* p, unsigned v) { return __hip_atomic_fetch_add(p, v, __ATOMIC_RELAXED, __HIP_MEMORY_SCOPE_AGENT); }
__device__ __forceinline__ unsigned xb_xcc_id() { return (unsigned)__builtin_amdgcn_s_getreg((3 << 11) | 20) & 0xFu; }
#define XB_SPIN(cond, bar) do { unsigned _sp = 0; while (cond) { __builtin_amdgcn_s_sleep(1); \
    if ((++_sp & 255u) == 0u) { if (xb_ld(&(bar)[XB_TMO])) break; if (_sp > XB_SPIN_CAP) { atomicAdd(&(bar)[XB_TMO], 1u); break; } } } } while (0)
struct XcdBarrier { unsigned x; volatile LAS unsigned* st; };
__device__ __forceinline__ XcdBarrier xcd_barrier_post(unsigned* bar, volatile LAS unsigned* st) {
    XcdBarrier b; b.x = xb_xcc_id(); b.st = st;
    if (threadIdx.x == 0) (void)xb_add(&bar[XB_XCNT(b.x)], 1u);
    return b;
}
__device__ __forceinline__ void xcd_barrier_complete(unsigned* bar, unsigned x, unsigned& nloc, unsigned& nx) {
    const unsigned G = gridDim.x * gridDim.y * gridDim.z;
    unsigned sum, cnt, mine, sp = 0u;
    for (;;) {
        sum = 0u; cnt = 0u; mine = 0u;
#pragma unroll
        for (unsigned j = 0; j < 16; ++j) { const unsigned c = xb_ld(&bar[XB_XCNT(j)]); sum += c; cnt += (c > 0u) ? 1u : 0u; mine = (j == x) ? c : mine; }
        if (sum == G) break;
        __builtin_amdgcn_s_sleep(1);
        if ((++sp & 255u) == 0u) { if (xb_ld(&bar[XB_TMO])) break; if (sp > XB_SPIN_CAP) { atomicAdd(&bar[XB_TMO], 1u); break; } }
    }
    nloc = mine > 0u ? mine : 1u; nx = cnt > 0u ? cnt : 1u;
}
__device__ __forceinline__ void xcd_barrier(const XcdBarrier& b, int wave_) {
    asm volatile("s_waitcnt vmcnt(0)" ::: "memory");
    __syncthreads();
    unsigned ones_ = ~0u; asm volatile("" : "+s"(ones_)); const int lane_ = __builtin_amdgcn_mbcnt_hi(ones_, __builtin_amdgcn_mbcnt_lo(ones_, 0u));
    if (wave_ == 0 && lane_ == 0) {
        unsigned* bar = (unsigned*)(ws_ptr() + WS_CTL) + 4096; unsigned bx_ = b.x; asm volatile("" : "+s"(bx_));
        __builtin_amdgcn_s_waitcnt(0);
        unsigned nloc = b.st[0], nx = b.st[1];
        if (nloc == 0u) { xcd_barrier_complete(bar, bx_, nloc, nx); b.st[0] = nloc; b.st[1] = nx; }
        const unsigned old = xb_add(&bar[XB_XSUB(bx_)], 1u);
        const unsigned gen = old / nloc;
        if (old + 1u == (gen + 1u) * nloc) {
            __builtin_amdgcn_fence(__ATOMIC_RELEASE, "agent");
            asm volatile("s_waitcnt vmcnt(0)" ::: "memory");
            const unsigned og = xb_add(&bar[XB_TOP], 1u);
            const unsigned tg = og / nx;
            if (og + 1u == (tg + 1u) * nx) xb_add(&bar[XB_TOPGEN], 1u);
            else XB_SPIN(xb_ld(&bar[XB_TOPGEN]) == tg, bar);
            __builtin_amdgcn_fence(__ATOMIC_ACQUIRE, "agent");
            xb_add(&bar[XB_XGEN(bx_)], 1u);
            asm volatile("s_waitcnt vmcnt(0)" ::: "memory");
        } else {
            XB_SPIN(xb_ld(&bar[XB_XGEN(bx_)]) == gen, bar);
            __builtin_amdgcn_fence(__ATOMIC_ACQUIRE, "agent");
            asm volatile("s_waitcnt vmcnt(0)" ::: "memory");
        }
    }
    __syncthreads();
}

struct Args { const float* in[29]; float* out; unsigned char* ws; int ph_lo, ph_hi; };

#define LDS_WAIT() asm volatile("s_waitcnt lgkmcnt(0)" ::: "memory")

__device__ __forceinline__ void p0_transpose_item(const float* W, int N, bf16_t* WT, int ldt, int coloff, int split, int add, LAS float* scr, int kb, int nb, int lane) {
    const int k0 = 64 * kb, n0 = 32 * nb;
#pragma unroll 8
    for (int i = 0; i < 32; ++i) { const int kk = 2 * i + (lane >> 5); scr[kk * 33 + (lane & 31)] = W[(size_t)(k0 + kk) * N + n0 + (lane & 31)]; }
    LDS_WAIT(); asm volatile("" ::: "memory");
    const int c = lane & 7;
#pragma unroll
    for (int j = 0; j < 4; ++j) { const int n = (lane >> 3) + 8 * j; const LAS float* s = scr + (8 * c) * 33 + n;
        u32x4 o; o.x = pk2(s[0 * 33], s[1 * 33]); o.y = pk2(s[2 * 33], s[3 * 33]); o.z = pk2(s[4 * 33], s[5 * 33]); o.w = pk2(s[6 * 33], s[7 * 33]);
        const int nn = n0 + n, row = nn < split ? nn : nn + add;
        *(u32x4*)(WT + (size_t)row * ldt + coloff + k0 + 8 * c) = o; }
    LDS_WAIT(); asm volatile("" ::: "memory");
}
__device__ __forceinline__ void p0_prologue(LAS unsigned char* lds, int vcu, int G, int wave, int lane, int tid) {
    LAS float* scr = (LAS float*)(lds + wave * 16384);
    const int gw = vcu * NWAVES + wave, NGW = G * NWAVES;
    unsigned char* ws = ws_ptr();
    constexpr int I_IN = (DM / 64) * (D_IN / 32);
    constexpr int I_BR = (BW / 64) * (DM / 32);
    constexpr int I_OUT = (DM / 64) * (DM / 32);
    constexpr int NITEMS = 2 * I_IN + 8 * I_BR + 2 * I_OUT;
    for (int it = gw; it < NITEMS; it += NGW) {
        int r = it;
        if (r < 2 * I_IN) { const int l = r / I_IN; r -= l * I_IN; const int nblk = D_IN / 32;
            p0_transpose_item(in_ptr<2>() + (size_t)l * DM * D_IN, D_IN, (bf16_t*)(ws + WS_WIN + l * SZ_WIN), DM, 0, NSPLIT, NH - NSPLIT, scr, r / nblk, r % nblk, lane); continue; }
        r -= 2 * I_IN;
        if (r < 8 * I_BR) { const int ln = r / I_BR; r -= ln * I_BR; const int l = ln >> 2, n = ln & 3; const int nblk = DM / 32;
            p0_transpose_item(in_ptr<25>() + (size_t)ln * BW * DM, DM, (bf16_t*)(ws + WS_WBR + l * SZ_W2), DM, n * BW, 1 << 30, 0, scr, r / nblk, r % nblk, lane); continue; }
        r -= 8 * I_BR;
        { const int l = r / I_OUT; r -= l * I_OUT; const int nblk = DM / 32;
            p0_transpose_item(in_ptr<26>() + (size_t)l * DM * DM, DM, (bf16_t*)(ws + WS_WOUT + l * SZ_W2), DM, 0, 1 << 30, 0, scr, r / nblk, r % nblk, lane); }
    }
    const int gt = vcu * NTHREADS + tid, NGT = G * NTHREADS;
    for (int i = gt; i < 2 * 32768; i += NGT) { const int l = i >> 15, j = i & 32767;
        unsigned z_ = 0u; asm volatile("" : "+v"(z_));
        *(u32x4*)(ws + WS_WIN + l * SZ_WIN + (size_t)NSPLIT * DM * 2 + (size_t)j * 16) = (u32x4){z_, z_, z_, z_}; }
    for (int i = gt; i < 2 * NPAD; i += NGT) { const int l = i / NPAD, n = i % NPAD; float v = 0.f;
        if (n < NSPLIT) v = in_ptr<3>()[(size_t)l * D_IN + n]; else if (n >= NH) v = in_ptr<3>()[(size_t)l * D_IN + n - (NH - NSPLIT)];
        ((float*)(ws + WS_BIN))[i] = v; }
    const float* x = in_ptr<0>(); bf16_t* xb = (bf16_t*)(ws + WS_XB);
    for (int i = gt; i < SEQ * DM / 8; i += NGT) { const f32x4 a = *(const f32x4*)(x + (size_t)i * 8), b = *(const f32x4*)(x + (size_t)i * 8 + 4);
        u32x4 o; o.x = pk2(a[0], a[1]); o.y = pk2(a[2], a[3]); o.z = pk2(b[0], b[1]); o.w = pk2(b[2], b[3]); *(u32x4*)(xb + (size_t)i * 8) = o; }
}

__device__ __forceinline__ void lru_pre_unit(int l, int unit, LAS unsigned char* lds, int tid) {
    unsigned char* ws = ws_ptr(); const bf16_t* H = (const bf16_t*)(ws + WS_H);
    LAS float* uL = (LAS float*)lds;
    const int c = tid, t0 = unit * 32;
    {
        const float* cw = in_ptr<4>() + (size_t)l * 4 * BW; const float w0 = cw[c], w1 = cw[BW + c], w2 = cw[2 * BW + c], w3 = cw[3 * BW + c], cb = in_ptr<5>()[l * BW + c];
        float x0 = t0 >= 3 ? bf2f(H[(size_t)(t0 - 3) * NH + O_AX + c]) : 0.f, x1 = t0 >= 2 ? bf2f(H[(size_t)(t0 - 2) * NH + O_AX + c]) : 0.f, x2 = t0 >= 1 ? bf2f(H[(size_t)(t0 - 1) * NH + O_AX + c]) : 0.f;
#pragma unroll 8
        for (int tt = 0; tt < 32; ++tt) { const float x3 = bf2f(H[(size_t)(t0 + tt) * NH + O_AX + c]);
            uL[tt * 512 + c] = cb + w0 * x0 + w1 * x1 + w2 * x2 + w3 * x3; x0 = x1; x1 = x2; x2 = x3; }
    }
    __syncthreads();
    const int g = c >> 6, j = c & 63;
    LAS float* aL = uL + 32 * 512;
    const float sp = softplusf(-in_ptr<10>()[l * BW + c]);
    {
        float Wa[64];
        { const float* pa = in_ptr<6>() + ((size_t)(l * 8 + g) * 64) * 64 + j;
#pragma unroll
          for (int i = 0; i < 64; ++i) Wa[i] = pa[i * 64]; }
        const float ba = in_ptr<7>()[l * BW + c];
#pragma unroll 2
        for (int tt = 0; tt < 32; ++tt) {
            float sa = ba;
            const LAS f32x4* up = (const LAS f32x4*)(uL + tt * 512 + g * 64);
#pragma unroll
            for (int i4 = 0; i4 < 16; ++i4) { const f32x4 uu = up[i4]; sa += uu[0] * Wa[4 * i4] + uu[1] * Wa[4 * i4 + 1] + uu[2] * Wa[4 * i4 + 2] + uu[3] * Wa[4 * i4 + 3]; }
            aL[tt * 512 + c] = -8.f * sigm(sa) * sp;
        }
    }
    asm volatile("" ::: "memory");
    float* HL = (float*)(ws + WS_HL); float* CA = (float*)(ws + WS_CA);
    float h = 0.f, ca = 1.f;
    {
        float Wx[64];
        { const float* px = in_ptr<8>() + ((size_t)(l * 8 + g) * 64) * 64 + j;
#pragma unroll
          for (int i = 0; i < 64; ++i) Wx[i] = px[i * 64]; }
        const float bx = in_ptr<9>()[l * BW + c];
#pragma unroll 2
        for (int tt = 0; tt < 32; ++tt) {
            float sx = bx;
            const LAS f32x4* up = (const LAS f32x4*)(uL + tt * 512 + g * 64);
#pragma unroll
            for (int i4 = 0; i4 < 16; ++i4) { const f32x4 uu = up[i4]; sx += uu[0] * Wx[4 * i4] + uu[1] * Wx[4 * i4 + 1] + uu[2] * Wx[4 * i4 + 2] + uu[3] * Wx[4 * i4 + 3]; }
            const float ig = sigm(sx), la = aL[tt * 512 + c], a = __expf(la), mult = sqrtf(-expm1f(2.f * la));
            const float b = mult * ig * uL[tt * 512 + c];
            h = a * h + b; ca *= a;
            HL[(size_t)(t0 + tt) * BW + c] = h; CA[(size_t)(t0 + tt) * BW + c] = ca;
        }
    }
    ((float*)(ws + WS_SA))[unit * BW + c] = ca; ((float*)(ws + WS_SH))[unit * BW + c] = h;
    __syncthreads();
}
__device__ __forceinline__ void lru_carry(int tid) {
    unsigned char* ws = ws_ptr(); const float* SA = (const float*)(ws + WS_SA); const float* SH = (const float*)(ws + WS_SH); float* CARRY = (float*)(ws + WS_CARRY);
    float carry = 0.f;
    for (int tb = 0; tb < 256; tb += 32) {
        float sa[32], sh[32];
#pragma unroll
        for (int i = 0; i < 32; ++i) { sa[i] = SA[(tb + i) * BW + tid]; sh[i] = SH[(tb + i) * BW + tid]; }
#pragma unroll
        for (int i = 0; i < 32; ++i) { CARRY[(tb + i) * BW + tid] = carry; carry = sa[i] * carry + sh[i]; }
    }
}
__device__ __forceinline__ void lru_post_unit(int unit, int tid) {
    unsigned char* ws = ws_ptr(); const bf16_t* H = (const bf16_t*)(ws + WS_H); const float* HL = (const float*)(ws + WS_HL); const float* CA = (const float*)(ws + WS_CA);
    bf16_t* YSG = (bf16_t*)(ws + WS_YSG);
    const float carry = ((const float*)(ws + WS_CARRY))[unit * BW + tid];
#pragma unroll 8
    for (int tt = 0; tt < 32; ++tt) { const size_t t = (size_t)unit * 32 + tt;
        const float h = HL[t * BW + tid] + CA[t * BW + tid] * carry; const float gt = bf2f(H[t * NH + O_AG + tid]);
        YSG[t * DM + tid] = (bf16_t)f2bf(h * silu(gt)); }
}

__device__ __forceinline__ void conf_unit(int l, int unit, LAS unsigned char* lds, int tid, int wave, int lane) {
    unsigned char* ws = ws_ptr(); const bf16_t* H = (const bf16_t*)(ws + WS_H); bf16_t* YSG = (bf16_t*)(ws + WS_YSG);
    LAS float* cu = (LAS float*)lds; LAS float* yL = (LAS float*)(lds + 46 * 512 * 4);
    const int c = tid, t0 = unit * 16;
#pragma unroll 2
    for (int rr = 0; rr < 46; ++rr) { const int t = t0 - 30 + rr; float v = 0.f;
        if (t >= 0) { const float dv = bf2f(H[(size_t)t * NH + O_DV + c]), dg = bf2f(H[(size_t)t * NH + O_DGLU + c]); v = dv * sigm(dg); }
        cu[rr * 512 + c] = v; }
    __syncthreads();
    {
        float w[31]; const float* cw = in_ptr<21>() + (size_t)l * 31 * BW + c;
#pragma unroll
        for (int j = 0; j < 31; ++j) w[j] = cw[j * BW];
        const float cb = in_ptr<22>()[l * BW + c];
        for (int tt = 0; tt < 16; ++tt) { float s = cb;
#pragma unroll
            for (int j = 0; j < 31; ++j) s += w[j] * cu[(tt + j) * 512 + c];
            yL[tt * 512 + c] = s; }
    }
    __syncthreads();
    const float* lg = in_ptr<23>() + l * BW; const float* lb = in_ptr<24>() + l * BW;
#pragma unroll
    for (int q = 0; q < 2; ++q) { const int tt = 2 * wave + q; const size_t t = (size_t)t0 + tt;
        float v[8]; float s = 0.f;
#pragma unroll
        for (int i = 0; i < 8; ++i) { v[i] = yL[tt * 512 + lane + 64 * i]; s += v[i]; }
        const float mean = wave_sum(s) * (1.f / 512.f); float s2 = 0.f;
#pragma unroll
        for (int i = 0; i < 8; ++i) { v[i] -= mean; s2 += v[i] * v[i]; }
        const float rstd = rsqrtf(wave_sum(s2) * (1.f / 512.f) + LN_EPS);
#pragma unroll
        for (int i = 0; i < 8; ++i) { const int ch = lane + 64 * i; const float yn = v[i] * rstd * lg[ch] + lb[ch];
            const float gt = bf2f(H[t * NH + O_DG + ch]);
            YSG[t * DM + 3 * BW + ch] = (bf16_t)f2bf(silu(yn) * silu(gt)); } }
    __syncthreads();
}

__device__ __forceinline__ void rwkv_prep_unit(int l, int unit, LAS unsigned char* lds, int tid) {
    unsigned char* ws = ws_ptr(); const bf16_t* H = (const bf16_t*)(ws + WS_H);
    LAS float* wdad = (LAS float*)lds;
    const int c = tid, t0 = unit * 32;
    const float* mu = in_ptr<11>() + (size_t)l * 1664;
    if (tid < 128) { const float m = mu[1536 + tid]; float prev = t0 > 0 ? bf2f(H[(size_t)(t0 - 1) * NH + O_CWD + tid]) : 0.f;
#pragma unroll 4
        for (int tt = 0; tt < 32; ++tt) { const float cur = bf2f(H[(size_t)(t0 + tt) * NH + O_CWD + tid]); float xs = cur + m * (prev - cur); prev = cur;
            if (tid < 64) xs = tanhf(xs); wdad[tt * 128 + tid] = xs; } }
    __syncthreads();
    float* RR = (float*)(ws + WS_RR);
    {
        float wup[64];
        { const float* pw = in_ptr<13>() + (size_t)l * 64 * BW + c;
#pragma unroll
          for (int i = 0; i < 64; ++i) wup[i] = pw[i * BW]; }
        const float w0c = in_ptr<12>()[l * BW + c];
#pragma unroll 2
        for (int tt = 0; tt < 32; ++tt) { float dw = 0.f; const LAS f32x4* wp = (const LAS f32x4*)(wdad + tt * 128);
#pragma unroll
            for (int i4 = 0; i4 < 16; ++i4) { const f32x4 a = wp[i4]; dw += a[0] * wup[4 * i4] + a[1] * wup[4 * i4 + 1] + a[2] * wup[4 * i4 + 2] + a[3] * wup[4 * i4 + 3]; }
            const float wl = -softplusf(-(w0c + dw)) - 0.5f;
            RR[(size_t)SEQ * BW + (size_t)(t0 + tt) * BW + c] = -__expf(wl); }
    }
    asm volatile("" ::: "memory");
    {
        float aup[64];
        { const float* pa = in_ptr<15>() + (size_t)l * 64 * BW + c;
#pragma unroll
          for (int i = 0; i < 64; ++i) aup[i] = pa[i * BW]; }
        const float mr = mu[c], mk = mu[BW + c], mv = mu[2 * BW + c];
        const float a0c = in_ptr<14>()[l * BW + c], kkc = in_ptr<16>()[l * BW + c], kac = in_ptr<17>()[l * BW + c], rkc = in_ptr<18>()[l * BW + c];
        float pr = 0.f, pk = 0.f, pv = 0.f;
        if (t0 > 0) { pr = bf2f(H[(size_t)(t0 - 1) * NH + O_CR + c]); pk = bf2f(H[(size_t)(t0 - 1) * NH + O_CK + c]); pv = bf2f(H[(size_t)(t0 - 1) * NH + O_CV + c]); }
#pragma unroll 2
        for (int tt = 0; tt < 32; ++tt) { const size_t t = (size_t)t0 + tt;
            const float cr = bf2f(H[t * NH + O_CR + c]), ck = bf2f(H[t * NH + O_CK + c]), cv = bf2f(H[t * NH + O_CV + c]);
            const float r = cr + mr * (pr - cr), kx = ck + mk * (pk - ck), vv = cv + mv * (pv - cv); pr = cr; pk = ck; pv = cv;
            float da = 0.f; const LAS f32x4* wp = (const LAS f32x4*)(wdad + tt * 128 + 64);
#pragma unroll
            for (int i4 = 0; i4 < 16; ++i4) { const f32x4 b = wp[i4]; da += b[0] * aup[4 * i4] + b[1] * aup[4 * i4 + 1] + b[2] * aup[4 * i4 + 2] + b[3] * aup[4 * i4 + 3]; }
            const float aicl = sigm(a0c + da);
            const float kkv = kx * kkc, ss = wave_sum(kkv * kkv), kkn = kkv / fmaxf(sqrtf(ss), 1e-12f);
            const float kc = kx * (1.f + (aicl - 1.f) * kac);
            const float bon = wave_sum(r * kc * rkc) * vv;
            const size_t o = t * BW + c;
            RR[o] = r; RR[2 * (size_t)SEQ * BW + o] = kc; RR[3 * (size_t)SEQ * BW + o] = vv;
            RR[4 * (size_t)SEQ * BW + o] = -kkn; RR[5 * (size_t)SEQ * BW + o] = kkn * aicl; RR[6 * (size_t)SEQ * BW + o] = bon;
        }
    }
    __syncthreads();
}

constexpr int LD68 = 68, MBUF = 64 * LD68 * 4;
#define MB(k) ((LAS float*)(lds + (k) * MBUF))
__device__ __forceinline__ void mm_nt(const LAS float* X, const LAS float* Y, int wave, int lane, f32x4& c0, f32x4& c1) {
    const int rs = lane & 15, kq = lane >> 4, ti = wave >> 1, tj = (wave & 1) * 2;
    const LAS f32x4* xa = (const LAS f32x4*)(X + (16 * ti + rs) * LD68 + 16 * kq);
    const LAS f32x4* y0 = (const LAS f32x4*)(Y + (16 * tj + rs) * LD68 + 16 * kq);
    const LAS f32x4* y1 = (const LAS f32x4*)(Y + (16 * tj + 16 + rs) * LD68 + 16 * kq);
    f32x4 a[4], b0[4], b1[4];
#pragma unroll
    for (int q = 0; q < 4; ++q) { a[q] = xa[q]; b0[q] = y0[q]; b1[q] = y1[q]; }
#pragma unroll
    for (int q = 0; q < 4; ++q)
#pragma unroll
        for (int e = 0; e < 4; ++e) { c0 = __builtin_amdgcn_mfma_f32_16x16x4f32(a[q][e], b0[q][e], c0, 0, 0, 0); c1 = __builtin_amdgcn_mfma_f32_16x16x4f32(a[q][e], b1[q][e], c1, 0, 0, 0); }
}
__device__ __forceinline__ void rwkv_c1_unit(int unit, LAS unsigned char* lds, int tid, int wave, int lane) {
    unsigned char* ws = ws_ptr();
    const int t0 = (unit >> 3) * 64, ch0 = (unit & 7) * 64;
    const float* RRp = (const float*)(ws + WS_RR); constexpr size_t PLn = (size_t)SEQ * BW;
    LAS float* segtot = (LAS float*)(lds + 8 * MBUF); LAS float* PL = segtot + 512;
    const int j = tid & 63, seg = wave;
    const float* gb = RRp + (size_t)(t0 + 8 * seg) * BW + ch0 + j;
#define C1_IDS int ln_ = lane; asm volatile("" : "+v"(ln_)); const int rs = ln_ & 15, kq = ln_ >> 4, ti = wave >> 1, tj = (wave & 1) * 2, row0 = 16 * ti + 4 * kq, col0 = 16 * tj + rs; \
    const int oc = row0 * LD68 + col0, otr = col0 * LD68 + row0; (void)oc; (void)otr; (void)rs; (void)kq;
    const int ow = (8 * seg) * LD68 + j;
    float lw[8], cl[8];
#pragma unroll
    for (int k = 0; k < 8; ++k) lw[k] = gb[PLn + (size_t)k * BW];
    { float run = 0.f;
#pragma unroll
      for (int k = 0; k < 8; ++k) { run += lw[k]; cl[k] = run; }
      segtot[seg * 64 + j] = run; }
    __syncthreads();
    { float off = 0.f, tot = 0.f;
#pragma unroll
      for (int s_ = 0; s_ < 8; ++s_) { const float v = segtot[s_ * 64 + j]; tot += v; off += (s_ < seg) ? v : 0.f; }
#pragma unroll
      for (int k = 0; k < 8; ++k) cl[k] += off;
      if (seg == 0) PL[j] = __expf(tot); }
#pragma unroll
    for (int k = 0; k < 8; ++k) {
        const float r = gb[(size_t)k * BW], kc = gb[2 * PLn + (size_t)k * BW], a = gb[4 * PLn + (size_t)k * BW], b = gb[5 * PLn + (size_t)k * BW];
        const float em = __expf(-cl[k]);
        MB(0)[ow + k * LD68] = a * __expf(cl[k] - lw[k]); MB(1)[ow + k * LD68] = r * __expf(cl[k]); MB(2)[ow + k * LD68] = b * em; MB(3)[ow + k * LD68] = kc * em; }
    __syncthreads();
#pragma unroll
    for (int p = 0; p < 4; ++p) { C1_IDS f32x4 c0 = (f32x4){0.f, 0.f, 0.f, 0.f}, c1 = c0;
        mm_nt(MB(p >> 1), MB(2 + (p & 1)), wave, ln_, c0, c1);
        LAS float* D = MB(4 + p) + oc;
#pragma unroll
        for (int e = 0; e < 4; ++e) { const int row = row0 + e;
            const bool k0 = (p < 2) ? (col0 < row) : (col0 <= row), k1 = (p < 2) ? (col0 + 16 < row) : (col0 + 16 <= row);
            D[e * LD68] = k0 ? c0[e] : 0.f; D[e * LD68 + 16] = k1 ? c1[e] : 0.f; } }
    __syncthreads();
    for (int idx = tid; idx < 4096; idx += NTHREADS) { const int i = idx >> 6, jx = idx & 63;
        if (i < jx) { const float u0 = MB(2)[i * LD68 + jx], u1 = MB(2)[jx * LD68 + i]; MB(2)[i * LD68 + jx] = u1; MB(2)[jx * LD68 + i] = u0; } }
    {   C1_IDS
        LAS float* xb = wave < 4 ? MB(0) + (16 * wave) * LD68 : MB(5) + (16 * (wave - 4)) * LD68;
        const LAS float* rsrc = (wave < 4 ? MB(0) + 16 * wave : MB(5) + 16 * (wave - 4)) + (4 * kq) * LD68 + rs;
        f32x4 rhs[4];
#pragma unroll
        for (int b = 0; b < 4; ++b)
#pragma unroll
            for (int e = 0; e < 4; ++e) rhs[b][e] = rsrc[(16 * b + e) * LD68];
        __syncthreads();
        LAS float* xt = xb + rs * LD68;
        const LAS float* ap = MB(4) + rs * LD68;
        int zoff = 0; asm volatile("" : "+v"(zoff));
        const LAS float* md = MB(4) + zoff;
#pragma unroll
        for (int b = 0; b < 4; ++b) {
            f32x4 cc = rhs[b];
            if (b > 0) {
#pragma unroll
                for (int g = 0; g < b; ++g) { const f32x4 av = *(const LAS f32x4*)(ap + 16 * b * LD68 + kq * 4 * b + 4 * g), bv = *(const LAS f32x4*)(xt + kq * 4 * b + 4 * g);
#pragma unroll
                    for (int e = 0; e < 4; ++e) cc = __builtin_amdgcn_mfma_f32_16x16x4f32(av[e], bv[e], cc, 0, 0, 0); } }
            *(LAS f32x4*)(xt + 16 * b + 4 * kq) = cc;
            __syncthreads();
            if (kq == 0) {
                float xx[16];
#pragma unroll
                for (int q = 0; q < 4; ++q) { const f32x4 v = *(const LAS f32x4*)(xt + 16 * b + 4 * q); xx[4 * q] = v[0]; xx[4 * q + 1] = v[1]; xx[4 * q + 2] = v[2]; xx[4 * q + 3] = v[3]; }
#pragma unroll
                for (int r = 1; r < 16; ++r) { float acc = xx[r];
#pragma unroll
                    for (int q = 0; q < (r + 3) / 4; ++q) { const f32x4 m = *(const LAS f32x4*)(md + (16 * b + r) * LD68 + 16 * b + 4 * q); acc += m[0] * xx[4 * q] + m[1] * xx[4 * q + 1] + m[2] * xx[4 * q + 2] + m[3] * xx[4 * q + 3]; }
                    xx[r] = acc; }
#pragma unroll
                for (int q = 0; q < 4; ++q) *(LAS f32x4*)(xt + 16 * b + 4 * q) = (f32x4){xx[4 * q], xx[4 * q + 1], xx[4 * q + 2], xx[4 * q + 3]};
            }
            __syncthreads();
        }
    }
    __syncthreads();
    float* gout = (float*)(ws + WS_GAMT) + (size_t)unit * 4096;
    constexpr size_t UMF = SZ_UM / 4;
    {
        C1_IDS f32x4 c0, c1;
#pragma unroll
        for (int e = 0; e < 4; ++e) { c0[e] = MB(1)[oc + e * LD68]; c1[e] = MB(1)[oc + e * LD68 + 16]; }
        mm_nt(MB(6), MB(0), wave, ln_, c0, c1);
        float* RH = gout + 2 * UMF + row0 * 64 + col0;
#pragma unroll
        for (int e = 0; e < 4; ++e) { RH[e * 64] = c0[e]; RH[e * 64 + 16] = c1[e]; } }
    {
        C1_IDS f32x4 c0, c1;
#pragma unroll
        for (int e = 0; e < 4; ++e) { c0[e] = MB(7)[oc + e * LD68]; c1[e] = MB(7)[oc + e * LD68 + 16]; }
        mm_nt(MB(6), MB(5), wave, ln_, c0, c1);
        float* WH = gout + 3 * UMF + row0 * 64 + col0;
#pragma unroll
        for (int e = 0; e < 4; ++e) { WH[e * 64] = c0[e]; WH[e * 64 + 16] = c1[e]; } }
    {
        C1_IDS f32x4 c0 = (f32x4){0.f, 0.f, 0.f, 0.f}, c1 = c0;
        mm_nt(MB(0), MB(2), wave, ln_, c0, c1);
        const float p0 = PL[col0], p1 = PL[col0 + 16];
#pragma unroll
        for (int e = 0; e < 4; ++e) { c0[e] = (c0[e] + ((row0 + e) == col0 ? 1.f : 0.f)) * p0; c1[e] = (c1[e] + ((row0 + e) == col0 + 16 ? 1.f : 0.f)) * p1; }
        float* GT = gout + col0 * 64 + row0;
        *(f32x4*)GT = c0; *(f32x4*)(GT + 16 * 64) = c1; }
    {
        C1_IDS f32x4 c0, c1;
#pragma unroll
        for (int e = 0; e < 4; ++e) { c0[e] = MB(3)[oc + e * LD68]; c1[e] = MB(3)[oc + e * LD68 + 16]; }
        mm_nt(MB(5), MB(2), wave, ln_, c0, c1);
        const float p0 = PL[col0], p1 = PL[col0 + 16];
        *(LAS f32x4*)(MB(4) + otr) = c0 * p0; *(LAS f32x4*)(MB(4) + otr + 16 * LD68) = c1 * p1; }
    float vreg[8];
#pragma unroll
    for (int k = 0; k < 8; ++k) vreg[k] = gb[3 * PLn + (size_t)k * BW];
    __syncthreads();
    *(LAS f32x4*)(MB(1) + j * LD68 + 8 * seg) = (f32x4){vreg[0], vreg[1], vreg[2], vreg[3]}; *(LAS f32x4*)(MB(1) + j * LD68 + 8 * seg + 4) = (f32x4){vreg[4], vreg[5], vreg[6], vreg[7]};
    __syncthreads();
    {
        C1_IDS f32x4 c0 = (f32x4){0.f, 0.f, 0.f, 0.f}, c1 = c0;
        mm_nt(MB(1), MB(4), wave, ln_, c0, c1);
        float* ZT = gout + UMF + col0 * 64 + row0;
        *(f32x4*)ZT = c0; *(f32x4*)(ZT + 16 * 64) = c1; }
    __syncthreads();
#undef C1_IDS
}
__device__ __forceinline__ void rwkv_chain(int h, LAS unsigned char* lds, int tid, int wave, int lane) {
    unsigned char* ws = ws_ptr();
    const int rs = lane & 15, kq = lane >> 4, ti = wave >> 1, tj = (wave & 1) * 2, row0 = 16 * ti + 4 * kq, col0 = 16 * tj + rs, col1 = col0 + 16;
    const float* GT = (const float*)(ws + WS_GAMT); const float* ZT = (const float*)(ws + WS_ZT); float* SST = (float*)(ws + WS_SST);
    for (int i = tid; i < 64 * LD68; i += NTHREADS) MB(0)[i] = 0.f;
    for (int i = tid; i < 4096; i += NTHREADS) SST[(size_t)h * 4096 + i] = 0.f;
    const int q0 = tid, q1 = tid + 512;
    { const float* g = GT + (size_t)h * 4096; const f32x4 g0 = *(const f32x4*)(g + q0 * 4), g1 = *(const f32x4*)(g + q1 * 4);
      *(LAS f32x4*)(MB(1) + (q0 >> 4) * LD68 + (q0 & 15) * 4) = g0; *(LAS f32x4*)(MB(1) + (q1 >> 4) * LD68 + (q1 & 15) * 4) = g1; }
    __syncthreads();
    for (int c = 0; c < SEQ / 64; ++c) {
        const size_t ub = (size_t)(c * 8 + h) * 4096, ubn = ub + 8 * 4096;
        f32x4 g0 = (f32x4){0.f, 0.f, 0.f, 0.f}, g1 = g0;
        if (c + 1 < SEQ / 64) { g0 = *(const f32x4*)(GT + ubn + q0 * 4); g1 = *(const f32x4*)(GT + ubn + q1 * 4); }
        f32x4 c0 = *(const f32x4*)(ZT + ub + col0 * 64 + row0), c1 = *(const f32x4*)(ZT + ub + col1 * 64 + row0);
        mm_nt(MB(0), MB(1 + (c & 1)), wave, lane, c0, c1);
        __syncthreads();
#pragma unroll
        for (int e = 0; e < 4; ++e) { MB(0)[(row0 + e) * LD68 + col0] = c0[e]; MB(0)[(row0 + e) * LD68 + col1] = c1[e]; }
        if (c + 1 < SEQ / 64) {
#pragma unroll
            for (int e = 0; e < 4; ++e) { SST[ubn + (row0 + e) * 64 + col0] = c0[e]; SST[ubn + (row0 + e) * 64 + col1] = c1[e]; }
            LAS float* gn = MB(1 + ((c + 1) & 1));
            *(LAS f32x4*)(gn + (q0 >> 4) * LD68 + (q0 & 15) * 4) = g0; *(LAS f32x4*)(gn + (q1 >> 4) * LD68 + (q1 & 15) * 4) = g1; }
        __syncthreads();
    }
}
#ifdef DIFFTEST
__device__ __forceinline__ float dpp_row_sum_total(float v) {
    v += __builtin_bit_cast(float, __builtin_amdgcn_update_dpp(0, __builtin_bit_cast(int, v), 0xB1, 0xF, 0xF, true));
    v += __builtin_bit_cast(float, __builtin_amdgcn_update_dpp(0, __builtin_bit_cast(int, v), 0x4E, 0xF, 0xF, true));
    v += __builtin_bit_cast(float, __builtin_amdgcn_update_dpp(0, __builtin_bit_cast(int, v), 0x141, 0xF, 0xF, true));
    v += __builtin_bit_cast(float, __builtin_amdgcn_update_dpp(0, __builtin_bit_cast(int, v), 0x140, 0xF, 0xF, true));
    v += __builtin_bit_cast(float, __builtin_amdgcn_update_dpp(0, __builtin_bit_cast(int, v), 0x142, 0xA, 0xF, false));
    v += __builtin_bit_cast(float, __builtin_amdgcn_update_dpp(0, __builtin_bit_cast(int, v), 0x143, 0xC, 0xF, false));
    return __builtin_bit_cast(float, __builtin_amdgcn_readlane(__builtin_bit_cast(int, v), 63));
}
__device__ __forceinline__ void rwkv_naive_scan_unit(int unit, LAS unsigned char* lds, int tid, int wave, int lane) {
    unsigned char* ws = ws_ptr();
    const int h = unit >> 3, i = (unit & 7) * 8 + wave, chi = h * 64 + i;
    const size_t PL = (size_t)SEQ * BW;
    const float* RRb = (const float*)(ws + WS_RR) + h * 64 + 4 * (lane & 15) + (size_t)(lane >> 4) * BW;
    float* WY = (float*)(ws + WS_WY) + (size_t)chi * SEQ;
    constexpr int STG = 6 * 32 * 64 * 4;
    float S = 0.f;
#define RW_ISSUE(st, buf) do { _Pragma("unroll") for (int q_ = 0; q_ < 6; ++q_) { const int id_ = wave * 6 + q_, arr_ = id_ >> 3, tq_ = id_ & 7; const int pl_ = arr_ < 3 ? arr_ : (arr_ == 3 ? 3 : arr_ + 0); \
        __builtin_amdgcn_global_load_lds((const unsigned*)(RRb + (size_t)pl_ * PL + (size_t)((st) * 32 + 4 * tq_) * BW), (LAS unsigned*)(lds + (buf) * STG + (arr_ * 32 + 4 * tq_) * 256), 16, 0, 0); } } while (0)
    RW_ISSUE(0, 0);
    asm volatile("s_waitcnt vmcnt(0)" ::: "memory"); __syncthreads();
    for (int st = 0; st < SEQ / 32; ++st) {
        const int buf = st & 1;
        if (st + 1 < SEQ / 32) RW_ISSUE(st + 1, buf ^ 1);
        const LAS float* Lb = (const LAS float*)(lds + buf * STG);
        float yacc = 0.f;
#pragma unroll 8
        for (int s_ = 0; s_ < 32; ++s_) {
            const float r = Lb[(0 * 32 + s_) * 64 + lane], w = __expf(Lb[(1 * 32 + s_) * 64 + lane]), k = Lb[(2 * 32 + s_) * 64 + lane], v = Lb[(3 * 32 + s_) * 64 + i],
                        a = Lb[(4 * 32 + s_) * 64 + lane], b = Lb[(5 * 32 + s_) * 64 + lane];
            const float sa = dpp_row_sum_total(S * a);
            S = S * w + (sa * b + v * k);
            const float y = dpp_row_sum_total(S * r);
            yacc = (lane == s_) ? y : yacc;
        }
        if (lane < 32) WY[st * 32 + lane] = yacc;
        asm volatile("s_waitcnt vmcnt(0)" ::: "memory"); __syncthreads();
    }
#undef RW_ISSUE
}
#endif
__device__ __forceinline__ void rwkv_c3_unit(int l, int unit, LAS unsigned char* lds, int tid, int wave, int lane) {
    unsigned char* ws = ws_ptr(); const bf16_t* H = (const bf16_t*)(ws + WS_H); bf16_t* YSG = (bf16_t*)(ws + WS_YSG);
    const int t0 = (unit >> 3) * 64, ch0 = (unit & 7) * 64;
    const float* RRp = (const float*)(ws + WS_RR); const size_t PLn = (size_t)SEQ * BW;
    const size_t ub = (size_t)unit * 4096;
    const int rs = lane & 15, kq = lane >> 4, ti = wave >> 1, tj = (wave & 1) * 2, row0 = 16 * ti + 4 * kq, col0 = 16 * tj + rs, col1 = col0 + 16;
    {   const float* s0 = (const float*)(ws + WS_RH) + ub; const float* s1 = (const float*)(ws + WS_SST) + ub; const float* s2 = (const float*)(ws + WS_WH) + ub;
#pragma unroll
        for (int k = 0; k < 2; ++k) { const int q = tid + 512 * k, o = (q >> 4) * LD68 + (q & 15) * 4;
            *(LAS f32x4*)(MB(0) + o) = *(const f32x4*)(s0 + q * 4); *(LAS f32x4*)(MB(1) + o) = *(const f32x4*)(s1 + q * 4); *(LAS f32x4*)(MB(2) + o) = *(const f32x4*)(s2 + q * 4); }
        const int j = tid & 63, seg = wave; const size_t base = (size_t)(t0 + 8 * seg) * BW + ch0 + j; float vreg[8];
#pragma unroll
        for (int k = 0; k < 8; ++k) vreg[k] = RRp[3 * PLn + base + (size_t)k * BW];
        *(LAS f32x4*)(MB(3) + j * LD68 + 8 * seg) = (f32x4){vreg[0], vreg[1], vreg[2], vreg[3]}; *(LAS f32x4*)(MB(3) + j * LD68 + 8 * seg + 4) = (f32x4){vreg[4], vreg[5], vreg[6], vreg[7]}; }
    __syncthreads();
    f32x4 c0 = (f32x4){0.f, 0.f, 0.f, 0.f}, c1 = c0;
    mm_nt(MB(0), MB(1), wave, lane, c0, c1);
    mm_nt(MB(2), MB(3), wave, lane, c0, c1);
#pragma unroll
    for (int e = 0; e < 4; ++e) { MB(4)[(row0 + e) * LD68 + col0] = c0[e]; MB(4)[(row0 + e) * LD68 + col1] = c1[e]; }
    __syncthreads();
    const int ch = ch0 + lane; const float gg = in_ptr<19>()[l * BW + ch], gb = in_ptr<20>()[l * BW + ch];
#pragma unroll 2
    for (int k = 0; k < 8; ++k) { const int tt = 8 * wave + k; const size_t t = (size_t)t0 + tt;
        float v = MB(4)[tt * LD68 + lane];
#ifdef DIFFTEST
        { const float vn = ((const float*)(ws + WS_WY))[(size_t)ch * SEQ + t]; if (DIFFCOND) v = vn; }
#endif
        const float mean = wave_sum(v) * (1.f / 64.f); const float d = v - mean; const float var = wave_sum(d * d) * (1.f / 64.f);
        const float y = d * rsqrtf(var + GN_EPS) * gg + gb + RRp[6 * PLn + t * BW + ch];
        const float gt = bf2f(H[t * NH + O_CG + ch]);
        YSG[t * DM + 2 * BW + ch] = (bf16_t)f2bf(y * silu(gt)); }
    __syncthreads();
}

constexpr int ATT_KS = 136, ATT_VS = 260, ATT_K_BYTES = 256 * ATT_KS * 2, ATT_V_BYTES = 128 * ATT_VS * 2;
__device__ __forceinline__ int t5_bucket(int dist) {
    if (dist < 16) return dist;
    const int thr[15] = {22, 30, 40, 54, 73, 99, 134, 182, 246, 332, 450, 609, 825, 1117, 1513};
    int b = 16;
#pragma unroll
    for (int i = 0; i < 15; ++i) b += (dist >= thr[i]) ? 1 : 0;
    return b;
}
__device__ __forceinline__ void att_unit(int unit, LAS unsigned char* lds, int tid, int wave, int lane) {
    unsigned char* ws = ws_ptr(); const bf16_t* H = (const bf16_t*)(ws + WS_H);
    const int g = unit >> 8, hh = (unit >> 6) & 3, b = unit & 63;
    const int dil = g == 0 ? 1 : (g == 1 ? 4 : 16), nb = 64 / dil, r = b / nb, n = b % nb, head = g * 4 + hh;
    LAS bf16_t* Ks = (LAS bf16_t*)lds; LAS bf16_t* Vt = (LAS bf16_t*)(lds + ATT_K_BYTES); LAS float* biasL = (LAS float*)(lds + ATT_K_BYTES + ATT_V_BYTES);
    if (tid < 176) { const int dd = tid - 16; biasL[tid] = (dd >= 0 && dd <= 128) ? in_ptr<1>()[t5_bucket(dd * dil) * 12 + head] : 0.f; }
#pragma unroll 2
    for (int it = 0; it < 8; ++it) { const int idx = it * 512 + tid, key = idx >> 4, chn = idx & 15; const int blk = n - 1 + (key >> 7);
        u32x4 kv = (u32x4){0u, 0u, 0u, 0u}, vv = (u32x4){0u, 0u, 0u, 0u};
        if (blk >= 0) { const size_t t = (size_t)r + (size_t)dil * (128 * blk + (key & 127)); const bf16_t* p = H + t * NH + head * 128 + chn * 8;
            kv = *(const u32x4*)(p + O_K); vv = *(const u32x4*)(p + O_V); }
        *(LAS u32x4*)(Ks + key * ATT_KS + chn * 8) = kv;
        LAS bf16_t* vp = Vt + (chn * 8) * ATT_VS + key;
        vp[0] = (bf16_t)(vv.x & 0xffff); vp[ATT_VS] = (bf16_t)(vv.x >> 16); vp[2 * ATT_VS] = (bf16_t)(vv.y & 0xffff); vp[3 * ATT_VS] = (bf16_t)(vv.y >> 16);
        vp[4 * ATT_VS] = (bf16_t)(vv.z & 0xffff); vp[5 * ATT_VS] = (bf16_t)(vv.z >> 16); vp[6 * ATT_VS] = (bf16_t)(vv.w & 0xffff); vp[7 * ATT_VS] = (bf16_t)(vv.w >> 16); }
    __syncthreads();
    const int fr = lane & 15, fq = lane >> 4, w = wave;
    const size_t tq = (size_t)r + (size_t)dil * (128 * n + 16 * w + fr);
    bf16x8 qf[4];
#pragma unroll
    for (int ks = 0; ks < 4; ++ks) qf[ks] = *(const bf16x8*)(H + tq * NH + O_Q + head * 128 + ks * 32 + fq * 8);
    f32x4 st[9];
#pragma unroll
    for (int kk = 0; kk < 9; ++kk) { st[kk] = (f32x4){0.f, 0.f, 0.f, 0.f}; const int kt = w + kk;
#pragma unroll
        for (int ks = 0; ks < 4; ++ks) { const bf16x8 kf = *(const LAS bf16x8*)(Ks + (16 * kt + fr) * ATT_KS + ks * 32 + fq * 8);
            st[kk] = __builtin_amdgcn_mfma_f32_16x16x32_bf16(kf, qf[ks], st[kk], 0, 0, 0); } }
    const float scale = 0.08838834764831845f; float mx = -1e30f;
    const int xo = 4 * fq - fr; const LAS float* bp = biasL + (16 + 128 - xo - 131);
#pragma unroll
    for (int kk = 0; kk < 9; ++kk) { const bool tile_ok = !(n == 0 && (w + kk) < 8);
#pragma unroll
        for (int e = 0; e < 4; ++e) { bool valid = tile_ok; if (kk == 0) valid = valid && (e + xo >= 0); if (kk == 8) valid = valid && (e + xo <= 0);
            const float lg = valid ? st[kk][e] * scale + bp[131 - (16 * kk + e)] : -1e30f; st[kk][e] = lg; mx = fmaxf(mx, lg); } }
    mx = fmaxf(mx, __shfl_xor(mx, 16)); mx = fmaxf(mx, __shfl_xor(mx, 32));
    float den = 0.f;
#pragma unroll
    for (int kk = 0; kk < 9; ++kk)
#pragma unroll
        for (int e = 0; e < 4; ++e) { const float p = __expf(st[kk][e] - mx); st[kk][e] = p; den += p; }
    den += __shfl_xor(den, 16); den += __shfl_xor(den, 32);
    f32x4 ot[8];
#pragma unroll
    for (int dt = 0; dt < 8; ++dt) ot[dt] = (f32x4){0.f, 0.f, 0.f, 0.f};
#pragma unroll
    for (int s = 0; s < 5; ++s) { const int kk0 = 2 * s, kk1 = 2 * s + 1;
        u32x4 pw; pw.x = pk2(st[kk0][0], st[kk0][1]); pw.y = pk2(st[kk0][2], st[kk0][3]);
        if (kk1 < 9) { pw.z = pk2(st[kk1 < 9 ? kk1 : 8][0], st[kk1 < 9 ? kk1 : 8][1]); pw.w = pk2(st[kk1 < 9 ? kk1 : 8][2], st[kk1 < 9 ? kk1 : 8][3]); } else { pw.z = 0u; pw.w = 0u; }
        const bf16x8 pb = __builtin_bit_cast(bf16x8, pw);
        const int kt0 = w + kk0; int kt1 = w + kk1; kt1 = kt1 > 15 ? 15 : kt1;
#pragma unroll
        for (int dt = 0; dt < 8; ++dt) { const LAS bf16_t* vr = Vt + (16 * dt + fr) * ATT_VS + 4 * fq;
            const u32x2 lo = *(const LAS u32x2*)(vr + 16 * kt0), hi = *(const LAS u32x2*)(vr + 16 * kt1);
            const u32x4 va = (u32x4){lo.x, lo.y, hi.x, hi.y};
            ot[dt] = __builtin_amdgcn_mfma_f32_16x16x32_bf16(__builtin_bit_cast(bf16x8, va), pb, ot[dt], 0, 0, 0); } }
    const float rden = 1.f / den;
    float* OG = (float*)(ws + WS_OG) + (size_t)g * SEQ * BW + tq * BW + hh * 128 + 4 * fq;
#pragma unroll
    for (int dt = 0; dt < 8; ++dt) *(f32x4*)(OG + 16 * dt) = ot[dt] * rden;
    if (fq == 0) { ((float*)(ws + WS_MG))[((size_t)g * SEQ + tq) * 4 + hh] = mx; ((float*)(ws + WS_DG))[((size_t)g * SEQ + tq) * 4 + hh] = den; }
    __syncthreads();
}
__device__ __forceinline__ void att_merge_unit(int unit, int tid) {
    unsigned char* ws = ws_ptr(); const bf16_t* H = (const bf16_t*)(ws + WS_H); bf16_t* YSG = (bf16_t*)(ws + WS_YSG);
    const float* OG = (const float*)(ws + WS_OG); const float* MG = (const float*)(ws + WS_MG); const float* DG = (const float*)(ws + WS_DG);
    const size_t t = (size_t)unit * 16 + (tid >> 5); const int c0 = (tid & 31) * 16, hh = c0 >> 7;
    float m[3], d[3];
#pragma unroll
    for (int g = 0; g < 3; ++g) { m[g] = MG[((size_t)g * SEQ + t) * 4 + hh]; d[g] = DG[((size_t)g * SEQ + t) * 4 + hh]; }
    const float mm = fmaxf(m[0], fmaxf(m[1], m[2]));
    float wt[3], ws_ = 0.f;
#pragma unroll
    for (int g = 0; g < 3; ++g) { wt[g] = __expf(m[g] - mm) * d[g]; ws_ += wt[g]; }
    const float inv = 1.f / ws_;
#pragma unroll
    for (int q = 0; q < 4; ++q) { f32x4 acc = (f32x4){0.f, 0.f, 0.f, 0.f};
#pragma unroll
        for (int g = 0; g < 3; ++g) acc += *(const f32x4*)(OG + ((size_t)g * SEQ + t) * BW + c0 + 4 * q) * wt[g];
        const u32x2 gw = *(const u32x2*)(H + t * NH + O_BG + c0 + 4 * q);
        u32x2 o; o.x = pk2(acc[0] * inv * silu(wlo(gw.x)), acc[1] * inv * silu(whi(gw.x))); o.y = pk2(acc[2] * inv * silu(wlo(gw.y)), acc[3] * inv * silu(whi(gw.y)));
        *(u32x2*)(YSG + t * DM + BW + c0 + 4 * q) = o; }
}

__device__ __forceinline__ void ln_row(const float* z, const float* g, const float* b, float* of, bf16_t* ob, int lane) {
    f32x4 v[8]; float s = 0.f;
#pragma unroll
    for (int j = 0; j < 8; ++j) { v[j] = *(const f32x4*)(z + 4 * lane + 256 * j); s += (v[j][0] + v[j][1]) + (v[j][2] + v[j][3]); }
    const float mean = wave_sum(s) * (1.f / DM); float s2 = 0.f;
#pragma unroll
    for (int j = 0; j < 8; ++j) { v[j] = v[j] - mean; s2 += (v[j][0] * v[j][0] + v[j][1] * v[j][1]) + (v[j][2] * v[j][2] + v[j][3] * v[j][3]); }
    const float rstd = rsqrtf(wave_sum(s2) * (1.f / DM) + LN_EPS);
#pragma unroll
    for (int j = 0; j < 8; ++j) { const int c = 4 * lane + 256 * j; const f32x4 gg = *(const f32x4*)(g + c), bb = *(const f32x4*)(b + c);
        const f32x4 o = v[j] * rstd * gg + bb; *(f32x4*)(of + c) = o;
        if (ob) { u32x2 w; w.x = pk2(o[0], o[1]); w.y = pk2(o[2], o[3]); *(u32x2*)(ob + c) = w; } }
}

constexpr int NPL = 8, NPHASE = 1 + DEPTH * NPL;
__global__ void __launch_bounds__(NTHREADS, 2) hybrid_fwd(Args args) {
    extern __shared__ __attribute__((aligned(16))) unsigned char lds_raw[];
    LAS unsigned char* lds = (LAS unsigned char*)lds_raw;
    const int tid0 = threadIdx.x; const int wave0 = __builtin_amdgcn_readfirstlane(tid0 >> 6);
    const int G = gridDim.x; const int bx0 = blockIdx.x;
    volatile LAS unsigned* MISC = (volatile LAS unsigned*)(lds + MISC_OFF);
    for (int u = tid0; u < (LDS_BYTES - RING_BYTES) / 4; u += NTHREADS) ((LAS unsigned*)(lds + RING_BYTES))[u] = 0u;
    __syncthreads();
    XcdBarrier bar; bar.x = 0; bar.st = nullptr;
    const bool multi = (args.ph_hi - args.ph_lo) > 1;
    if (multi) bar = xcd_barrier_post((unsigned*)(ws_ptr() + WS_CTL) + 4096, MISC + 8);

    for (int ph = args.ph_lo; ph < args.ph_hi; ++ph) {
      const int sel_ = ph == 0 ? 0 : 1 + (ph - 1) % NPL; const int nrep_ = (sel_ == RPT_SEL) ? 2 : 1;
      for (int rep_ = 0; rep_ < nrep_; ++rep_) {
#define FRESH_IDS int bx = bx0, wave = wave0; asm volatile("" : "+s"(bx)); asm volatile("" : "+s"(wave)); \
        unsigned ones_ = ~0u; asm volatile("" : "+s"(ones_)); const int lane = __builtin_amdgcn_mbcnt_hi(ones_, __builtin_amdgcn_mbcnt_lo(ones_, 0u)); \
        const int tid = wave * 64 + lane; const int vcu = (G % 8 == 0) ? (bx % 8) * (G / 8) + bx / 8 : bx; (void)tid; (void)vcu; (void)lane;
        if (ph == 0) {
            FRESH_IDS

            p0_prologue(lds, vcu, G, wave, lane, tid);
        } else {
            const int l = (ph - 1) / NPL, sp = (ph - 1) % NPL;
            if (sp == 0) {
                FRESH_IDS
                unsigned char* ws = ws_ptr();
                pg8::Gemm g{(const bf16_t*)(ws + WS_XB), (const bf16_t*)(ws + WS_WIN + l * SZ_WIN), SEQ, NPAD, DM, DM, DM};
                pg8::StaticOrder S; S.init(SEQ, NPAD, G, bx);
                pg8::EpiIn E{(bf16_t*)(ws + WS_H), (bf16_t*)(ws + WS_G), (const float*)(ws + WS_BIN) + l * NPAD};

                pg8::gemm_phase<pg8::EpiIn, pg8::StaticOrder, true>(lds, g, S, E, tid);
            } else if (sp == 1) {
                FRESH_IDS
                for (int u = vcu; u < 256; u += G) lru_pre_unit(l, u, lds, tid);
                for (int u = vcu; u < 512; u += G) conf_unit(l, u, lds, tid, wave, lane);
                for (int u = vcu; u < 256; u += G) rwkv_prep_unit(l, u, lds, tid);
            } else if (sp == 2) {
                FRESH_IDS
#if !defined(NO_C1)
                for (int u = vcu; u < 1024; u += G) rwkv_c1_unit(u, lds, tid, wave, lane);
#endif
            } else if (sp == 3) {
                FRESH_IDS
#if !defined(NO_CH)
                if (vcu < 8) rwkv_chain(vcu, lds, tid, wave, lane);
                else
#endif
                { if (vcu == G - 1) lru_carry(tid);
#ifdef DIFFTEST
                  if (vcu < 72) rwkv_naive_scan_unit(vcu - 8, lds, tid, wave, lane);
#endif
                  for (int u = vcu - 8; u < 768; u += G - 8) att_unit(u, lds, tid, wave, lane); }
            } else if (sp == 4) {
                FRESH_IDS
#if !defined(NO_C3)
                for (int u = vcu; u < 1024; u += G) rwkv_c3_unit(l, u, lds, tid, wave, lane);
#endif
                for (int u = vcu; u < 256; u += G) lru_post_unit(u, tid);
                for (int u = vcu; u < 512; u += G) att_merge_unit(u, tid);
            } else if (sp == 5) {
                FRESH_IDS
                unsigned char* ws = ws_ptr();
                pg8::StaticOrder S; S.init(SEQ, DM, G, bx);
                const bf16_t* Gm = (const bf16_t*)(ws + WS_G); float* MIXF = (float*)(ws + WS_MIXF); bf16_t* MIX = (bf16_t*)(ws + WS_MIX);
                const bf16_t* Ab = (const bf16_t*)(ws + WS_YSG); const bf16_t* Bb = (const bf16_t*)(ws + WS_WBR + l * SZ_W2);
                { pg8::Gemm g{Ab, Bb, SEQ, DM, BW, DM, DM}; pg8::EpiMix<0> E{Gm, 0, MIXF, MIX}; pg8::gemm_phase<pg8::EpiMix<0>, pg8::StaticOrder, true>(lds, g, S, E, tid); }
                { pg8::Gemm g{Ab + BW, Bb + BW, SEQ, DM, BW, DM, DM}; pg8::EpiMix<1> E{Gm, DM, MIXF, MIX}; pg8::gemm_phase<pg8::EpiMix<1>, pg8::StaticOrder, true>(lds, g, S, E, tid); }
                { pg8::Gemm g{Ab + 2 * BW, Bb + 2 * BW, SEQ, DM, BW, DM, DM}; pg8::EpiMix<1> E{Gm, 2 * DM, MIXF, MIX}; pg8::gemm_phase<pg8::EpiMix<1>, pg8::StaticOrder, true>(lds, g, S, E, tid); }
                { pg8::Gemm g{Ab + 3 * BW, Bb + 3 * BW, SEQ, DM, BW, DM, DM}; pg8::EpiMix<2> E{Gm, 3 * DM, MIXF, MIX}; pg8::gemm_phase<pg8::EpiMix<2>, pg8::StaticOrder, true>(lds, g, S, E, tid); }
            } else if (sp == 6) {
                FRESH_IDS
                unsigned char* ws = ws_ptr();
                pg8::Gemm g{(const bf16_t*)(ws + WS_MIX), (const bf16_t*)(ws + WS_WOUT + l * SZ_W2), SEQ, DM, DM, DM, DM};
                pg8::StaticOrder S; S.init(SEQ, DM, G, bx);
                pg8::EpiOut E{l == 0 ? in_ptr<0>() : (const float*)(ws + WS_XF), (float*)(ws + WS_Z)};

                pg8::gemm_phase<pg8::EpiOut, pg8::StaticOrder, true>(lds, g, S, E, tid);
            } else {
                FRESH_IDS
                unsigned char* ws = ws_ptr();
                const float* Z = (const float*)(ws + WS_Z); const float* lg = in_ptr<27>() + l * DM; const float* lb = in_ptr<28>() + l * DM;
                float* of = l == DEPTH - 1 ? out_ptr() : (float*)(ws + WS_XF); bf16_t* ob = l == DEPTH - 1 ? nullptr : (bf16_t*)(ws + WS_XB);
                for (int row = vcu * NWAVES + wave; row < SEQ; row += G * NWAVES) ln_row(Z + (size_t)row * DM, lg, lb, of + (size_t)row * DM, ob ? ob + (size_t)row * DM : nullptr, lane);
            }
        }
        if (ph + 1 < args.ph_hi || rep_ + 1 < nrep_) { int wv_ = wave0; asm volatile("" : "+s"(wv_)); xcd_barrier(bar, wv_); }
      }
    }
}

extern "C" void kernel_launch(void* const* d_in, const int* in_sizes, int n_in, void* d_out, int out_size, void* d_ws, size_t ws_size, hipStream_t stream) {
    static int grid = 0;
    if (grid == 0) {
        if (n_in != 29 || out_size != SEQ * DM || ws_size < WS_END) { fprintf(stderr, "kernel_launch: unexpected shapes (n_in %d, out %d, ws %zu, need %zu)\n", n_in, out_size, ws_size, (size_t)WS_END); grid = -1; return; }
        int dev = 0, cus = 0;
        if (hipGetDevice(&dev) != hipSuccess || hipDeviceGetAttribute(&cus, hipDeviceAttributeMultiprocessorCount, dev) != hipSuccess) { grid = -1; return; }
        if (hipFuncSetAttribute((const void*)hybrid_fwd, hipFuncAttributeMaxDynamicSharedMemorySize, LDS_BYTES) != hipSuccess) { fprintf(stderr, "kernel_launch: hipFuncSetAttribute failed\n"); grid = -1; return; }
        int per_cu = 0;
        if (hipOccupancyMaxActiveBlocksPerMultiprocessor(&per_cu, (const void*)hybrid_fwd, NTHREADS, LDS_BYTES) != hipSuccess || per_cu < 1) fprintf(stderr, "kernel_launch: occupancy query reports %d\n", per_cu);
        (void)hipGetLastError();
        grid = cus;
    }
    if (grid < 0) return;
    (void)hipMemsetAsync((char*)d_ws + WS_CTL, 0, CTL_ZERO_BYTES, stream);
    Args a{};
    for (int i = 0; i < 29; ++i) a.in[i] = (const float*)d_in[i];
    a.out = (float*)d_out; a.ws = (unsigned char*)d_ws;
#if MK_ONE_LAUNCH
    a.ph_lo = 0; a.ph_hi = NPHASE;
    hipLaunchKernelGGL(hybrid_fwd, dim3(grid), dim3(NTHREADS), LDS_BYTES, stream, a);
#else
    for (int ph = 0; ph < NPHASE; ++ph) { a.ph_lo = ph; a.ph_hi = ph + 1; hipLaunchKernelGGL(hybrid_fwd, dim3(grid), dim3(NTHREADS), LDS_BYTES, stream, a); }
#endif
}
```

```cpp
#include <hip/hip_runtime.h>
#include <cstdio>
#include <cstdint>

#ifndef MK_ONE_LAUNCH
#define MK_ONE_LAUNCH 1
#endif
#ifndef RPT_SEL
#define RPT_SEL -1
#endif
#define LAS __attribute__((address_space(3)))
#define GAS __attribute__((address_space(1)))
typedef unsigned short bf16_t;
typedef short bf16x8 __attribute__((ext_vector_type(8)));
typedef float f32x4 __attribute__((ext_vector_type(4)));
typedef float f32x2 __attribute__((ext_vector_type(2)));
typedef unsigned u32x4 __attribute__((ext_vector_type(4)));
typedef unsigned u32x2 __attribute__((ext_vector_type(2)));

constexpr int SEQ = 8192, DM = 2048, DEPTH = 2, BW = 512, D_IN = 18048;
constexpr int NSPLIT = 9856;
constexpr int NH = 9984;
constexpr int NPAD = NH + 8192;
constexpr int NT_H = NH / 256;
constexpr int O_AX = 0, O_AG = 512, O_Q = 1024, O_K = 2560, O_V = 4096, O_BG = 5632, O_CR = 6144, O_CK = 6656, O_CV = 7168, O_CWD = 7680,
              O_CAD = 7744, O_CG = 7808, O_DV = 8320, O_DGLU = 8832, O_DG = 9344;
constexpr float ALPHA = 1.41421356237309515f;
constexpr float LN_EPS = 1e-5f, GN_EPS = 64e-5f;

__device__ __forceinline__ float bf2f(unsigned b) { return __uint_as_float(b << 16); }
__device__ __forceinline__ unsigned f2bf(float f) { unsigned u = __float_as_uint(f); return (u + 0x7fffu + ((u >> 16) & 1u)) >> 16; }
__device__ __forceinline__ unsigned pk2(float lo, float hi) { return f2bf(lo) | (f2bf(hi) << 16); }
__device__ __forceinline__ float wlo(unsigned w) { return __uint_as_float(w << 16); }
__device__ __forceinline__ float whi(unsigned w) { return __uint_as_float(w & 0xffff0000u); }
__device__ __forceinline__ float sigm(float x) { return 1.f / (1.f + __expf(-x)); }
__device__ __forceinline__ float silu(float x) { return x / (1.f + __expf(-x)); }
__device__ __forceinline__ float softplusf(float y) { return fmaxf(y, 0.f) + log1pf(__expf(-fabsf(y))); }
__device__ __forceinline__ float wave_sum(float v) {
#pragma unroll
    for (int o = 1; o < 64; o <<= 1) v += __shfl_xor(v, o);
    return v;
}

__device__ __forceinline__ float wave_sum_dpp(float v) {
    v += __builtin_bit_cast(float, __builtin_amdgcn_update_dpp(0, __builtin_bit_cast(int, v), 0xB1, 0xF, 0xF, true));
    v += __builtin_bit_cast(float, __builtin_amdgcn_update_dpp(0, __builtin_bit_cast(int, v), 0x4E, 0xF, 0xF, true));
    v += __builtin_bit_cast(float, __builtin_amdgcn_update_dpp(0, __builtin_bit_cast(int, v), 0x141, 0xF, 0xF, true));
    v += __builtin_bit_cast(float, __builtin_amdgcn_update_dpp(0, __builtin_bit_cast(int, v), 0x140, 0xF, 0xF, true));
    v += __builtin_bit_cast(float, __builtin_amdgcn_update_dpp(0, __builtin_bit_cast(int, v), 0x142, 0xA, 0xF, false));
    v += __builtin_bit_cast(float, __builtin_amdgcn_update_dpp(0, __builtin_bit_cast(int, v), 0x143, 0xC, 0xF, false));
    return __builtin_bit_cast(float, __builtin_amdgcn_readlane(__builtin_bit_cast(int, v), 63));
}

namespace pg8 {
constexpr int BM = 256, BK = 64, HALF = 128, HTB = HALF * BK * 2, STAGE_BYTES = 8 * HTB, NXCD = 8, WGM = 8;
__host__ __device__ __forceinline__ int lds_byte(int r, int c) { const int st = (r >> 4) * 2 + (c >> 5), rr = r & 15, cc = c & 31, ob = rr * 64 + cc * 2; return st * 1024 + (ob ^ (((ob >> 9) & 1) << 5)); }
__host__ __device__ __forceinline__ void stage_rc(int b, int& R, int& C) { const int st = b / 1024, sb = b % 1024, swz = sb ^ (((sb >> 9) & 1) << 5); R = (st >> 1) * 16 + swz / 64; C = (st & 1) * 32 + (swz % 64) / 2; }
__host__ __device__ __forceinline__ int perm32(int rho) { const int n = rho >> 4, i = rho & 15; return 8 * (i >> 2) + 4 * n + (i & 3); }

struct Unit { int pm, pn; };
struct Gemm { const bf16_t* A; const bf16_t* Bt; int M, N, K, lda, ldb; };

struct StaticOrder {
    int nM, nN, nwg, G, c;
    __device__ void init(int M, int N, int G_, int c_) { nM = M / BM; nN = N / BM; nwg = nM * nN; G = G_; c = c_; }
    __device__ bool next(int i, Unit& u) const {
        const long L = (long)i * G + c; if (L >= nwg) return false;
        int wgid = (int)L; { const int q = nwg / NXCD, r = nwg % NXCD, xcd = wgid % NXCD, off = wgid / NXCD; wgid = (xcd < r ? xcd * (q + 1) : r * (q + 1) + (xcd - r) * q) + off; }
        const int nig = WGM * nN, gid = wgid / nig, fm = gid * WGM, gsz = (nM - fm) < WGM ? (nM - fm) : WGM;
        u.pm = fm + ((wgid % nig) % gsz); u.pn = (wgid % nig) / gsz; return true;
    }
};

__device__ __forceinline__ unsigned cvt_pk_bf16(float lo, float hi) { unsigned r; asm volatile("v_cvt_pk_bf16_f32 %0, %1, %2" : "=v"(r) : "v"(lo), "v"(hi)); return r; }


struct EpiIn {
    static constexpr bool PERM = true;
    bf16_t* H; bf16_t* G; const float* bias;
    __device__ __forceinline__ void operator()(const f32x4 (&acc)[2][2][4][2], const Unit& u, int wr, int wc, int fr, int fq) const {
        const int row0 = u.pm * BM + wr * 64 + fr, bcol0 = u.pn * BM + wc * 32 + 8 * fq;
        const bool isg = u.pn >= NT_H;
        bf16_t* base = isg ? G : H; const int ldc = isg ? 8192 : NH; const int col0 = isg ? bcol0 - NH : bcol0;
        f32x4 bv[2][2];
#pragma unroll
        for (int bj = 0; bj < 2; ++bj)
#pragma unroll
            for (int n = 0; n < 2; ++n) bv[bj][n] = *(const f32x4*)(bias + bcol0 + bj * HALF + 4 * n);
#pragma unroll
        for (int ai = 0; ai < 2; ++ai)
#pragma unroll
            for (int m = 0; m < 4; ++m) { bf16_t* rowp = base + (size_t)(row0 + ai * HALF + m * 16) * ldc + col0;
#pragma unroll
                for (int bj = 0; bj < 2; ++bj) { f32x4 v0 = acc[ai][bj][m][0] + bv[bj][0], v1 = acc[ai][bj][m][1] + bv[bj][1];
                    if (isg) {
#pragma unroll
                        for (int e = 0; e < 4; ++e) { v0[e] = __builtin_amdgcn_rcpf(1.f + __expf(-v0[e])); v1[e] = __builtin_amdgcn_rcpf(1.f + __expf(-v1[e])); } }
                    u32x4 w; w.x = cvt_pk_bf16(v0[0], v0[1]); w.y = cvt_pk_bf16(v0[2], v0[3]); w.z = cvt_pk_bf16(v1[0], v1[1]); w.w = cvt_pk_bf16(v1[2], v1[3]);
                    *(u32x4*)(rowp + bj * HALF) = w; } }
    }
};
template <int MODE> struct EpiMix {
    static constexpr bool PERM = true;
    const bf16_t* G; int gcol; float* MIXF; bf16_t* MIX;
    __device__ __forceinline__ void operator()(const f32x4 (&acc)[2][2][4][2], const Unit& u, int wr, int wc, int fr, int fq) const {
        const int row0 = u.pm * BM + wr * 64 + fr, col0 = u.pn * BM + wc * 32 + 8 * fq;
#pragma unroll
        for (int ai = 0; ai < 2; ++ai)
#pragma unroll
            for (int m = 0; m < 4; ++m) { const size_t row = (size_t)(row0 + ai * HALF + m * 16);
#pragma unroll
                for (int bj = 0; bj < 2; ++bj) { const int c = col0 + bj * HALF;
                    const u32x4 gv = *(const u32x4*)(G + row * 8192 + gcol + c);
                    f32x4 v0 = acc[ai][bj][m][0], v1 = acc[ai][bj][m][1];
                    v0[0] *= wlo(gv.x); v0[1] *= whi(gv.x); v0[2] *= wlo(gv.y); v0[3] *= whi(gv.y);
                    v1[0] *= wlo(gv.z); v1[1] *= whi(gv.z); v1[2] *= wlo(gv.w); v1[3] *= whi(gv.w);
                    float* mp = MIXF + row * DM + c;
                    if (MODE >= 1) { v0 += *(const f32x4*)mp; v1 += *(const f32x4*)(mp + 4); }
                    if (MODE <= 1) { *(f32x4*)mp = v0; *(f32x4*)(mp + 4) = v1; }
                    else { u32x4 w; w.x = cvt_pk_bf16(v0[0], v0[1]); w.y = cvt_pk_bf16(v0[2], v0[3]); w.z = cvt_pk_bf16(v1[0], v1[1]); w.w = cvt_pk_bf16(v1[2], v1[3]);
                        *(u32x4*)(MIX + row * DM + c) = w; } }
                asm volatile("" ::: "memory"); }
    }
};
struct EpiOut {
    static constexpr bool PERM = true;
    const float* xres; float* Z;
    __device__ __forceinline__ void operator()(const f32x4 (&acc)[2][2][4][2], const Unit& u, int wr, int wc, int fr, int fq) const {
        const int row0 = u.pm * BM + wr * 64 + fr, col0 = u.pn * BM + wc * 32 + 8 * fq;
#pragma unroll
        for (int ai = 0; ai < 2; ++ai)
#pragma unroll
            for (int m = 0; m < 4; ++m) { const size_t row = (size_t)(row0 + ai * HALF + m * 16);
#pragma unroll
                for (int bj = 0; bj < 2; ++bj) { const size_t off = row * DM + col0 + bj * HALF;
                    const f32x4 x0 = *(const f32x4*)(xres + off), x1 = *(const f32x4*)(xres + off + 4);
                    *(f32x4*)(Z + off) = x0 * ALPHA + acc[ai][bj][m][0]; *(f32x4*)(Z + off + 4) = x1 * ALPHA + acc[ai][bj][m][1]; }
                asm volatile("" ::: "memory"); }
    }
};

template <class Epi, class Sched, bool ALIGN_EPI>
__device__ __forceinline__ void gemm_phase(LAS unsigned char* lds, const Gemm g, const Sched& S, const Epi& E, const int tid) {
    const int wid = __builtin_amdgcn_readfirstlane(tid >> 6), lane = tid & 63, wr = wid >> 2, wc = wid & 3, fr = lane & 15, fq = lane >> 4;
    const int K = g.K, nt = K / BK;
    unsigned voffA[2], voffB[2];
#pragma unroll
    for (int i = 0; i < 2; ++i) { int R, C; stage_rc(tid * 16 + i * 8192, R, C); const int Rb = Epi::PERM ? ((R & ~31) + perm32(R & 31)) : R;
        voffA[i] = (unsigned)(R * g.lda + C) * 2u; voffB[i] = (unsigned)(Rb * g.ldb + C) * 2u; }
    const size_t kstep = (size_t)(BK * 2);
    const size_t hstepA = (size_t)HALF * g.lda * 2, hstepB = (size_t)HALF * g.ldb * 2;
    const size_t tstepA = 2 * hstepA, tstepB = 2 * hstepB;
    const unsigned ldsw = (unsigned)wid * 1024u;
    const int aoff = lds_byte(wr * 64 + fr, fq * 8), boff = lds_byte(wc * 32 + fr, fq * 8);
#define PG8_SA(b, h) (((b) * 2 + (h)) * HTB)
#define PG8_SB(b, h) ((4 + (b) * 2 + (h)) * HTB)
#define PG8_STAGE(bufoff, gbase, voff) do { _Pragma("unroll") for (int _i = 0; _i < 2; ++_i) \
        __builtin_amdgcn_global_load_lds((const unsigned*)((const char*)(gbase) + (voff)[_i]), (LAS unsigned*)(lds + (bufoff) + ldsw + _i * 8192), 16, 0, 0); } while (0)
#define PG8_LDA(dst, b, h) do { _Pragma("unroll") for (int m = 0; m < 4; ++m) _Pragma("unroll") for (int k = 0; k < 2; ++k) dst[m][k] = *(const LAS bf16x8*)(lds + PG8_SA(b, h) + aoff + m * 2048 + k * 1024); } while (0)
#define PG8_LDB(dst, b, h) do { _Pragma("unroll") for (int n = 0; n < 2; ++n) _Pragma("unroll") for (int k = 0; k < 2; ++k) dst[n][k] = *(const LAS bf16x8*)(lds + PG8_SB(b, h) + boff + n * 2048 + k * 1024); } while (0)
#define PG8_MMA(ai, bj, At, Bt) do { __builtin_amdgcn_s_setprio(1); _Pragma("unroll") for (int m = 0; m < 4; ++m) _Pragma("unroll") for (int n = 0; n < 2; ++n) _Pragma("unroll") for (int k = 0; k < 2; ++k) \
        acc[ai][bj][m][n] = __builtin_amdgcn_mfma_f32_16x16x32_bf16(Bt[n][k], At[m][k], acc[ai][bj][m][n], 0, 0, 0); __builtin_amdgcn_s_setprio(0); } while (0)
#define PG8_WAIT_V(n) asm volatile("s_waitcnt vmcnt(" #n ")" ::: "memory")
#define PG8_WAIT_L(n) asm volatile("s_waitcnt lgkmcnt(" #n ")" ::: "memory")
#define PG8_BAR __builtin_amdgcn_s_barrier()
#define PG8_SCHED __builtin_amdgcn_sched_barrier(0)
    Unit cur, nxt; int ui = 0;
    if (!S.next(0, cur)) return;
    f32x4 acc[2][2][4][2];
#pragma unroll
    for (int a = 0; a < 2; ++a)
#pragma unroll
        for (int b = 0; b < 2; ++b)
#pragma unroll
            for (int m = 0; m < 4; ++m)
#pragma unroll
                for (int n = 0; n < 2; ++n) { float z_ = 0.f; asm volatile("" : "+v"(z_)); acc[a][b][m][n] = (f32x4){z_, z_, z_, z_}; }
    bf16x8 At[4][2], B0[2][2], B1[2][2];
    const char* cA = (const char*)g.A + (size_t)cur.pm * tstepA; const char* cB = (const char*)g.Bt + (size_t)cur.pn * tstepB;
    PG8_STAGE(PG8_SB(0, 0), cB, voffB); PG8_STAGE(PG8_SB(0, 1), cB + hstepB, voffB); PG8_STAGE(PG8_SA(0, 0), cA, voffA); PG8_STAGE(PG8_SA(0, 1), cA + hstepA, voffA);
    if (wr == 1) PG8_BAR;
    PG8_WAIT_V(2); PG8_BAR;
    PG8_STAGE(PG8_SB(1, 0), cB + kstep, voffB); PG8_STAGE(PG8_SA(1, 0), cA + kstep, voffA); PG8_STAGE(PG8_SB(1, 1), cB + hstepB + kstep, voffB);
    PG8_WAIT_V(6); PG8_BAR;
    for (;;) {
        const bool has_next = S.next(ui + 1, nxt);
        const char* nA = has_next ? (const char*)g.A + (size_t)nxt.pm * tstepA : cA; const char* nB = has_next ? (const char*)g.Bt + (size_t)nxt.pn * tstepB : cB;
        for (int t = 0; t < nt; t += 2) {
            const bool last = (t == nt - 2);
            const char* a1 = cA + (size_t)(t + 1) * kstep;
            const char* a2 = last ? nA : cA + (size_t)(t + 2) * kstep; const char* b2 = last ? nB : cB + (size_t)(t + 2) * kstep;
            const char* a3 = a2 + kstep; const char* b3 = b2 + kstep;
            PG8_LDB(B0, 0, 0); PG8_LDB(B1, 0, 1); PG8_SCHED; PG8_LDA(At, 0, 0); PG8_STAGE(PG8_SA(1, 1), a1 + hstepA, voffA);
            PG8_WAIT_V(8); PG8_WAIT_L(0); PG8_BAR; PG8_MMA(0, 0, At, B0); PG8_MMA(0, 1, At, B1); PG8_BAR; PG8_SCHED;
            PG8_LDA(At, 0, 1); PG8_STAGE(PG8_SB(0, 0), b2, voffB); PG8_STAGE(PG8_SB(0, 1), b2 + hstepB, voffB); PG8_STAGE(PG8_SA(0, 0), a2, voffA);
            PG8_WAIT_V(8); PG8_WAIT_L(0); PG8_BAR; PG8_MMA(1, 0, At, B0); PG8_MMA(1, 1, At, B1); PG8_BAR; PG8_SCHED;
            PG8_LDB(B0, 1, 0); PG8_LDB(B1, 1, 1); PG8_SCHED; PG8_LDA(At, 1, 0); PG8_STAGE(PG8_SA(0, 1), a2 + hstepA, voffA);
            PG8_WAIT_V(8); PG8_WAIT_L(0); PG8_BAR; PG8_MMA(0, 0, At, B0); PG8_MMA(0, 1, At, B1); PG8_BAR; PG8_SCHED;
            PG8_LDA(At, 1, 1); PG8_STAGE(PG8_SB(1, 0), b3, voffB); PG8_STAGE(PG8_SB(1, 1), b3 + hstepB, voffB); PG8_STAGE(PG8_SA(1, 0), a3, voffA);
            PG8_WAIT_V(8); PG8_WAIT_L(0); PG8_BAR; PG8_MMA(1, 0, At, B0); PG8_MMA(1, 1, At, B1); PG8_BAR; PG8_SCHED;
        }
        if constexpr (ALIGN_EPI) { if (wr == 0) PG8_BAR; }
        E(acc, cur, wr, wc, fr, fq);
        if (!has_next) break;
#pragma unroll
        for (int a = 0; a < 2; ++a)
#pragma unroll
            for (int b = 0; b < 2; ++b)
#pragma unroll
                for (int m = 0; m < 4; ++m)
#pragma unroll
                    for (int n = 0; n < 2; ++n) acc[a][b][m][n] = (f32x4){0.f, 0.f, 0.f, 0.f};
        cur = nxt; cA = nA; cB = nB; ++ui;
        if constexpr (ALIGN_EPI) { if (wr == 1) PG8_BAR; }
    }
    PG8_WAIT_V(0);
    if constexpr (!ALIGN_EPI) { if (wr == 0) PG8_BAR; }
    PG8_BAR;
#undef PG8_SA
#undef PG8_SB
#undef PG8_STAGE
#undef PG8_LDA
#undef PG8_LDB
#undef PG8_MMA
#undef PG8_WAIT_V
#undef PG8_WAIT_L
#undef PG8_BAR
#undef PG8_SCHED
}
}

constexpr size_t MiB = 1u << 20;
constexpr size_t al256(size_t x) { return (x + 255) & ~(size_t)255; }
constexpr size_t WS_CTL = 0, CTL_ZERO_BYTES = 1 * MiB;
constexpr size_t SZ_WIN = (size_t)NPAD * DM * 2, SZ_W2 = (size_t)DM * DM * 2, SZ_ACT_F32 = (size_t)SEQ * DM * 4, SZ_ACT_BF = (size_t)SEQ * DM * 2, SZ_BR_F32 = (size_t)SEQ * BW * 4;
constexpr size_t WS_WIN = 1 * MiB;
constexpr size_t WS_WBR = WS_WIN + 2 * SZ_WIN;
constexpr size_t WS_WOUT = WS_WBR + 2 * SZ_W2;
constexpr size_t WS_BIN = WS_WOUT + 2 * SZ_W2;
constexpr size_t WS_XB = al256(WS_BIN + 2 * (size_t)NPAD * 4);
constexpr size_t WS_XF = WS_XB + SZ_ACT_BF;
constexpr size_t WS_H = WS_XF + SZ_ACT_F32;
constexpr size_t WS_MIXF = WS_H;
constexpr size_t WS_Z = WS_H + SZ_ACT_F32;
constexpr size_t WS_G = WS_H + (size_t)SEQ * NH * 2;
constexpr size_t WS_YSG = WS_G + (size_t)SEQ * 8192 * 2;
constexpr size_t WS_MIX = WS_YSG + SZ_ACT_BF;
constexpr size_t WS_OG = WS_MIX + SZ_ACT_BF;
constexpr size_t WS_MG = WS_OG + 3 * SZ_BR_F32;
constexpr size_t WS_DG = WS_MG + 3 * (size_t)SEQ * 4 * 4;
constexpr size_t WS_HL = WS_DG + 3 * (size_t)SEQ * 4 * 4;
constexpr size_t WS_CA = WS_HL + SZ_BR_F32;
constexpr size_t WS_SA = WS_CA + SZ_BR_F32;
constexpr size_t WS_SH = WS_SA + 256 * 512 * 4;
constexpr size_t WS_CARRY = WS_SH + 256 * 512 * 4;
constexpr size_t WS_RR = WS_CARRY + 256 * 512 * 4;
constexpr size_t WS_WY = WS_RR + 7 * SZ_BR_F32;
constexpr size_t SZ_UM = (size_t)1024 * 64 * 64 * 4;
constexpr size_t WS_GAMT = WS_WY + SZ_BR_F32;
constexpr size_t WS_ZT = WS_GAMT + SZ_UM;
constexpr size_t WS_RH = WS_ZT + SZ_UM;
constexpr size_t WS_WH = WS_RH + SZ_UM;
constexpr size_t WS_SST = WS_WH + SZ_UM;
constexpr size_t WS_END = WS_SST + SZ_UM;
static_assert(WS_Z + SZ_ACT_F32 <= WS_G, "MIXF and Z overlay H");

constexpr int RING_BYTES = 143360;
constexpr int MISC_OFF = RING_BYTES + 320;
constexpr int LDS_BYTES = 151552;
constexpr int NWAVES = 8, NTHREADS = 512;

template <int OFF> __device__ __forceinline__ unsigned long long karg64() {
    auto kp = __builtin_amdgcn_kernarg_segment_ptr(); unsigned long long p;
    asm volatile("s_load_dwordx2 %0, %1, %2\n\ts_waitcnt lgkmcnt(0)" : "=s"(p) : "s"(kp), "i"(OFF) : "memory");
    return p;
}
template <int I> __device__ __forceinline__ const float* in_ptr() { return (const float*)karg64<8 * I>(); }
__device__ __forceinline__ float* out_ptr() { return (float*)karg64<232>(); }
__device__ __forceinline__ unsigned char* ws_ptr() { return (unsigned char*)karg64<240>(); }
#define XB_TMO      128
#define XB_XCNT(j)  (256  + 64 * (j))
#define XB_XSUB(j)  (1280 + 64 * (j))
#define XB_XGEN(j)  (2304 + 64 * (j))
#define XB_TOP      3328
#define XB_TOPGEN   3392
#define XCD_BAR_WORDS 3456
#define XB_SPIN_CAP (1u << 18)
__device__ __forceinline__ unsigned xb_ld(unsigned* p)              { return __hip_atomic_load(p, __ATOMIC_RELAXED, __HIP_MEMORY_SCOPE_AGENT); }
__device__ __forceinline__ unsigned xb_add(unsigned* p, unsigned v) { return __hip_atomic_fetch_add(p, v, __ATOMIC_RELAXED, __HIP_MEMORY_SCOPE_AGENT); }
__device__ __forceinline__ unsigned xb_xcc_id() { return (unsigned)__builtin_amdgcn_s_getreg((3 << 11) | 20) & 0xFu; }
#define XB_SPIN(cond, bar) do { unsigned _sp = 0; while (cond) { __builtin_amdgcn_s_sleep(1); \
    if ((++_sp & 255u) == 0u) { if (xb_ld(&(bar)[XB_TMO])) break; if (_sp > XB_SPIN_CAP) { atomicAdd(&(bar)[XB_TMO], 1u); break; } } } } while (0)
struct XcdBarrier { unsigned x; volatile LAS unsigned* st; };
__device__ __forceinline__ XcdBarrier xcd_barrier_post(unsigned* bar, volatile LAS unsigned* st) {
    XcdBarrier b; b.x = xb_xcc_id(); b.st = st;
    if (threadIdx.x == 0) (void)xb_add(&bar[XB_XCNT(b.x)], 1u);
    return b;
}
__device__ __forceinline__ void xcd_barrier_complete(unsigned* bar, unsigned x, unsigned& nloc, unsigned& nx) {
    const unsigned G = gridDim.x * gridDim.y * gridDim.z;
    unsigned sum, cnt, mine, sp = 0u;
    for (;;) {
        sum = 0u; cnt = 0u; mine = 0u;
#pragma unroll
        for (unsigned j = 0; j < 16; ++j) { const unsigned c = xb_ld(&bar[XB_XCNT(j)]); sum += c; cnt += (c > 0u) ? 1u : 0u; mine = (j == x) ? c : mine; }
        if (sum == G) break;
        __builtin_amdgcn_s_sleep(1);
        if ((++sp & 255u) == 0u) { if (xb_ld(&bar[XB_TMO])) break; if (sp > XB_SPIN_CAP) { atomicAdd(&bar[XB_TMO], 1u); break; } }
    }
    nloc = mine > 0u ? mine : 1u; nx = cnt > 0u ? cnt : 1u;
}
__device__ __forceinline__ void xcd_barrier(const XcdBarrier& b, int wave_) {
    asm volatile("s_waitcnt vmcnt(0)" ::: "memory");
    __syncthreads();
    unsigned ones_ = ~0u; asm volatile("" : "+s"(ones_)); const int lane_ = __builtin_amdgcn_mbcnt_hi(ones_, __builtin_amdgcn_mbcnt_lo(ones_, 0u));
    if (wave_ == 0 && lane_ == 0) {
        unsigned* bar = (unsigned*)(ws_ptr() + WS_CTL) + 4096; unsigned bx_ = b.x; asm volatile("" : "+s"(bx_));
        __builtin_amdgcn_s_waitcnt(0);
        unsigned nloc = b.st[0], nx = b.st[1];
        if (nloc == 0u) { xcd_barrier_complete(bar, bx_, nloc, nx); b.st[0] = nloc; b.st[1] = nx; }
        const unsigned old = xb_add(&bar[XB_XSUB(bx_)], 1u);
        const unsigned gen = old / nloc;
        if (old + 1u == (gen + 1u) * nloc) {
            __builtin_amdgcn_fence(__ATOMIC_RELEASE, "agent");
            asm volatile("s_waitcnt vmcnt(0)" ::: "memory");
            const unsigned og = xb_add(&bar[XB_TOP], 1u);
            const unsigned tg = og / nx;
            if (og + 1u == (tg + 1u) * nx) xb_add(&bar[XB_TOPGEN], 1u);
            else XB_SPIN(xb_ld(&bar[XB_TOPGEN]) == tg, bar);
            __builtin_amdgcn_fence(__ATOMIC_ACQUIRE, "agent");
            xb_add(&bar[XB_XGEN(bx_)], 1u);
            asm volatile("s_waitcnt vmcnt(0)" ::: "memory");
        } else {
            XB_SPIN(xb_ld(&bar[XB_XGEN(bx_)]) == gen, bar);
            __builtin_amdgcn_fence(__ATOMIC_ACQUIRE, "agent");
            asm volatile("s_waitcnt vmcnt(0)" ::: "memory");
        }
    }
    __syncthreads();
}

struct Args { const float* in[29]; float* out; unsigned char* ws; int ph_lo, ph_hi; };

#define LDS_WAIT() asm volatile("s_waitcnt lgkmcnt(0)" ::: "memory")

__device__ __forceinline__ void p0_transpose_item(const float* W, int N, bf16_t* WT, int ldt, int coloff, int split, int add, LAS float* scr, int kb, int nb, int lane) {
    const int k0 = 64 * kb, n0 = 64 * nb;
    const float* src = W + (size_t)(k0 + (lane >> 4)) * N + n0 + 4 * (lane & 15);
    f32x4 v[16];
#pragma unroll
    for (int i = 0; i < 16; ++i) v[i] = *(const f32x4*)(src + (size_t)(4 * i) * N);
    LAS float* wp = scr + (4 * (lane & 15)) * 65 + (lane >> 4);
#pragma unroll
    for (int i = 0; i < 16; ++i) { wp[4 * i] = v[i][0]; wp[65 + 4 * i] = v[i][1]; wp[130 + 4 * i] = v[i][2]; wp[195 + 4 * i] = v[i][3]; }
    LDS_WAIT(); asm volatile("" ::: "memory");
    const int c = lane & 7;
#pragma unroll
    for (int j = 0; j < 8; ++j) { const int n = (lane >> 3) + 8 * j; const LAS float* s_ = scr + n * 65 + 8 * c;
        u32x4 o; o.x = pk2(s_[0], s_[1]); o.y = pk2(s_[2], s_[3]); o.z = pk2(s_[4], s_[5]); o.w = pk2(s_[6], s_[7]);
        const int nn = n0 + n, row = nn < split ? nn : nn + add;
        *(u32x4*)(WT + (size_t)row * ldt + coloff + k0 + 8 * c) = o; }
    LDS_WAIT(); asm volatile("" ::: "memory");
}
__device__ __forceinline__ void p0_prologue(LAS unsigned char* lds, int vcu, int G, int wave, int lane, int tid) {
    LAS float* scr = (LAS float*)(lds + wave * 16640);
    const int gw = vcu * NWAVES + wave, NGW = G * NWAVES;
    unsigned char* ws = ws_ptr();
    constexpr int I_IN = (DM / 64) * (D_IN / 64);
    constexpr int I_BR = (BW / 64) * (DM / 64);
    constexpr int I_OUT = (DM / 64) * (DM / 64);
    constexpr int NITEMS = 2 * I_IN + 8 * I_BR + 2 * I_OUT;
    for (int it = gw; it < NITEMS; it += NGW) {
        int r = it;
        if (r < 2 * I_IN) { const int l = r / I_IN; r -= l * I_IN; const int nblk = D_IN / 64;
            p0_transpose_item(in_ptr<2>() + (size_t)l * DM * D_IN, D_IN, (bf16_t*)(ws + WS_WIN + l * SZ_WIN), DM, 0, NSPLIT, NH - NSPLIT, scr, r / nblk, r % nblk, lane); continue; }
        r -= 2 * I_IN;
        if (r < 8 * I_BR) { const int ln = r / I_BR; r -= ln * I_BR; const int l = ln >> 2, n = ln & 3; const int nblk = DM / 64;
            p0_transpose_item(in_ptr<25>() + (size_t)ln * BW * DM, DM, (bf16_t*)(ws + WS_WBR + l * SZ_W2), DM, n * BW, 1 << 30, 0, scr, r / nblk, r % nblk, lane); continue; }
        r -= 8 * I_BR;
        { const int l = r / I_OUT; r -= l * I_OUT; const int nblk = DM / 64;
            p0_transpose_item(in_ptr<26>() + (size_t)l * DM * DM, DM, (bf16_t*)(ws + WS_WOUT + l * SZ_W2), DM, 0, 1 << 30, 0, scr, r / nblk, r % nblk, lane); }
    }
    const int gt = vcu * NTHREADS + tid, NGT = G * NTHREADS;
    for (int i = gt; i < 2 * 32768; i += NGT) { const int l = i >> 15, j = i & 32767;
        unsigned z_ = 0u; asm volatile("" : "+v"(z_));
        *(u32x4*)(ws + WS_WIN + l * SZ_WIN + (size_t)NSPLIT * DM * 2 + (size_t)j * 16) = (u32x4){z_, z_, z_, z_}; }
    for (int i = gt; i < 2 * NPAD; i += NGT) { const int l = i / NPAD, n = i % NPAD; float v = 0.f;
        if (n < NSPLIT) v = in_ptr<3>()[(size_t)l * D_IN + n]; else if (n >= NH) v = in_ptr<3>()[(size_t)l * D_IN + n - (NH - NSPLIT)];
        ((float*)(ws + WS_BIN))[i] = v; }
    const float* x = in_ptr<0>(); bf16_t* xb = (bf16_t*)(ws + WS_XB);
    for (int i = gt; i < SEQ * DM / 8; i += NGT) { const f32x4 a = *(const f32x4*)(x + (size_t)i * 8), b = *(const f32x4*)(x + (size_t)i * 8 + 4);
        u32x4 o; o.x = pk2(a[0], a[1]); o.y = pk2(a[2], a[3]); o.z = pk2(b[0], b[1]); o.w = pk2(b[2], b[3]); *(u32x4*)(xb + (size_t)i * 8) = o; }
}

__device__ __forceinline__ void lru_pre_unit(int l, int unit, LAS unsigned char* lds, int tid) {
    unsigned char* ws = ws_ptr(); const bf16_t* H = (const bf16_t*)(ws + WS_H);
    LAS float* uL = (LAS float*)lds;
    const int c = tid, t0 = unit * 32;
    {
        LAS bf16_t* xin = (LAS bf16_t*)(uL + 32 * 512);
        u32x4 xv[5];
#pragma unroll
        for (int i = 0; i < 5; ++i) { const int it = tid + 512 * i, rr = it >> 6, chn = it & 63, t = t0 - 3 + rr; xv[i] = (u32x4){0u, 0u, 0u, 0u};
            if (rr < 35 && t >= 0) xv[i] = *(const u32x4*)(H + (size_t)t * NH + O_AX + chn * 8); }
#pragma unroll
        for (int i = 0; i < 5; ++i) { const int it = tid + 512 * i, rr = it >> 6, chn = it & 63; if (rr < 35) *(LAS u32x4*)(xin + rr * 512 + chn * 8) = xv[i]; }
        __syncthreads();
        const float* cw = in_ptr<4>() + (size_t)l * 4 * BW; const float w0 = cw[c], w1 = cw[BW + c], w2 = cw[2 * BW + c], w3 = cw[3 * BW + c], cb = in_ptr<5>()[l * BW + c];
        float x0 = bf2f(xin[c]), x1 = bf2f(xin[512 + c]), x2 = bf2f(xin[1024 + c]);
#pragma unroll 8
        for (int tt = 0; tt < 32; ++tt) { const float x3 = bf2f(xin[(tt + 3) * 512 + c]);
            uL[tt * 512 + c] = cb + w0 * x0 + w1 * x1 + w2 * x2 + w3 * x3; x0 = x1; x1 = x2; x2 = x3; }
    }
    __syncthreads();
    const int g = c >> 6, j = c & 63;
    LAS float* aL = uL + 32 * 512;
    const float sp = softplusf(-in_ptr<10>()[l * BW + c]);
    {
        float Wa[64];
        { const float* pa = in_ptr<6>() + ((size_t)(l * 8 + g) * 64) * 64 + j;
#pragma unroll
          for (int i = 0; i < 64; ++i) Wa[i] = pa[i * 64]; }
        const float ba = in_ptr<7>()[l * BW + c];
#pragma unroll 2
        for (int tt = 0; tt < 32; ++tt) {
            float sa = ba;
            const LAS f32x4* up = (const LAS f32x4*)(uL + tt * 512 + g * 64);
#pragma unroll
            for (int i4 = 0; i4 < 16; ++i4) { const f32x4 uu = up[i4]; sa += uu[0] * Wa[4 * i4] + uu[1] * Wa[4 * i4 + 1] + uu[2] * Wa[4 * i4 + 2] + uu[3] * Wa[4 * i4 + 3]; }
            aL[tt * 512 + c] = -8.f * sigm(sa) * sp;
        }
    }
    asm volatile("" ::: "memory");
    float* HL = (float*)(ws + WS_HL); float* CA = (float*)(ws + WS_CA);
    float h = 0.f, ca = 1.f;
    {
        float Wx[64];
        { const float* px = in_ptr<8>() + ((size_t)(l * 8 + g) * 64) * 64 + j;
#pragma unroll
          for (int i = 0; i < 64; ++i) Wx[i] = px[i * 64]; }
        const float bx = in_ptr<9>()[l * BW + c];
#pragma unroll 2
        for (int tt = 0; tt < 32; ++tt) {
            float sx = bx;
            const LAS f32x4* up = (const LAS f32x4*)(uL + tt * 512 + g * 64);
#pragma unroll
            for (int i4 = 0; i4 < 16; ++i4) { const f32x4 uu = up[i4]; sx += uu[0] * Wx[4 * i4] + uu[1] * Wx[4 * i4 + 1] + uu[2] * Wx[4 * i4 + 2] + uu[3] * Wx[4 * i4 + 3]; }
            const float ig = sigm(sx), la = aL[tt * 512 + c], a = __expf(la), mult = sqrtf(-expm1f(2.f * la));
            const float b = mult * ig * uL[tt * 512 + c];
            h = a * h + b; ca *= a;
            HL[(size_t)(t0 + tt) * BW + c] = h; CA[(size_t)(t0 + tt) * BW + c] = ca;
        }
    }
    ((float*)(ws + WS_SA))[unit * BW + c] = ca; ((float*)(ws + WS_SH))[unit * BW + c] = h;
    __syncthreads();
}
__device__ __forceinline__ void lru_post_unit(int unit, int tid) {
    unsigned char* ws = ws_ptr(); const bf16_t* H = (const bf16_t*)(ws + WS_H); const float* HL = (const float*)(ws + WS_HL); const float* CA = (const float*)(ws + WS_CA);
    const float* SA = (const float*)(ws + WS_SA); const float* SH = (const float*)(ws + WS_SH);
    bf16_t* YSG = (bf16_t*)(ws + WS_YSG);
    float carry = 0.f;
    for (int tb = 0; tb < unit; tb += 32) {
        float sa[32], sh[32];
#pragma unroll
        for (int i = 0; i < 32; ++i) { const bool ok = tb + i < unit; sa[i] = ok ? SA[(tb + i) * BW + tid] : 1.f; sh[i] = ok ? SH[(tb + i) * BW + tid] : 0.f; }
#pragma unroll
        for (int i = 0; i < 32; ++i) carry = sa[i] * carry + sh[i];
    }
#pragma unroll 8
    for (int tt = 0; tt < 32; ++tt) { const size_t t = (size_t)unit * 32 + tt;
        const float h = HL[t * BW + tid] + CA[t * BW + tid] * carry; const float gt = bf2f(H[t * NH + O_AG + tid]);
        YSG[t * DM + tid] = (bf16_t)f2bf(h * silu(gt)); }
}

__device__ __forceinline__ void conf_unit(int l, int unit, LAS unsigned char* lds, int tid, int wave, int lane) {
    unsigned char* ws = ws_ptr(); const bf16_t* H = (const bf16_t*)(ws + WS_H); bf16_t* YSG = (bf16_t*)(ws + WS_YSG);
    LAS float* cu = (LAS float*)lds; LAS float* yL = (LAS float*)(lds + 46 * 512 * 4);
    const int c = tid, t0 = unit * 16;
    {   u32x4 dvv[6], dgg[6];
#pragma unroll
        for (int i = 0; i < 6; ++i) { const int it = tid + 512 * i, rr = it >> 6, chn = it & 63, t = t0 - 30 + rr;
            dvv[i] = (u32x4){0u, 0u, 0u, 0u}; dgg[i] = dvv[i];
            if (rr < 46 && t >= 0) { const bf16_t* p = H + (size_t)t * NH + chn * 8; dvv[i] = *(const u32x4*)(p + O_DV); dgg[i] = *(const u32x4*)(p + O_DGLU); } }
#pragma unroll
        for (int i = 0; i < 6; ++i) { const int it = tid + 512 * i, rr = it >> 6, chn = it & 63;
            if (rr < 46) { const u32x4 a = dvv[i], g = dgg[i];
                *(LAS f32x4*)(cu + rr * 512 + chn * 8) = (f32x4){wlo(a.x) * sigm(wlo(g.x)), whi(a.x) * sigm(whi(g.x)), wlo(a.y) * sigm(wlo(g.y)), whi(a.y) * sigm(whi(g.y))};
                *(LAS f32x4*)(cu + rr * 512 + chn * 8 + 4) = (f32x4){wlo(a.z) * sigm(wlo(g.z)), whi(a.z) * sigm(whi(g.z)), wlo(a.w) * sigm(wlo(g.w)), whi(a.w) * sigm(whi(g.w))}; } }
    }
    __syncthreads();
    {
        float w[31]; const float* cw = in_ptr<21>() + (size_t)l * 31 * BW + c;
#pragma unroll
        for (int j = 0; j < 31; ++j) w[j] = cw[j * BW];
        const float cb = in_ptr<22>()[l * BW + c];
        for (int tt = 0; tt < 16; ++tt) { float s = cb;
#pragma unroll
            for (int j = 0; j < 31; ++j) s += w[j] * cu[(tt + j) * 512 + c];
            yL[tt * 512 + c] = s; }
    }
    __syncthreads();
    const float* lg = in_ptr<23>() + l * BW; const float* lb = in_ptr<24>() + l * BW;
#pragma unroll
    for (int q = 0; q < 2; ++q) { const int tt = 2 * wave + q; const size_t t = (size_t)t0 + tt;
        float v[8]; float s = 0.f;
#pragma unroll
        for (int i = 0; i < 8; ++i) { v[i] = yL[tt * 512 + lane + 64 * i]; s += v[i]; }
        const float mean = wave_sum(s) * (1.f / 512.f); float s2 = 0.f;
#pragma unroll
        for (int i = 0; i < 8; ++i) { v[i] -= mean; s2 += v[i] * v[i]; }
        const float rstd = rsqrtf(wave_sum(s2) * (1.f / 512.f) + LN_EPS);
#pragma unroll
        for (int i = 0; i < 8; ++i) { const int ch = lane + 64 * i; const float yn = v[i] * rstd * lg[ch] + lb[ch];
            const float gt = bf2f(H[t * NH + O_DG + ch]);
            YSG[t * DM + 3 * BW + ch] = (bf16_t)f2bf(silu(yn) * silu(gt)); } }
    __syncthreads();
}

__device__ __forceinline__ void rwkv_prep_unit(int l, int unit, LAS unsigned char* lds, int tid) {
    unsigned char* ws = ws_ptr(); const bf16_t* H = (const bf16_t*)(ws + WS_H);
    LAS bf16_t* cin = (LAS bf16_t*)lds;
    LAS float* wdad = (LAS float*)(lds + 110592);
    const int c = tid, t0 = unit * 32;
    const float* mu = in_ptr<11>() + (size_t)l * 1664;
    {
#pragma unroll
        for (int bt = 0; bt < 2; ++bt) { u32x4 xv[7];
#pragma unroll
            for (int i = 0; i < 7; ++i) { const int it = tid + 512 * (7 * bt + i), rr = it / 208, chn = it - rr * 208, t = t0 - 1 + rr; xv[i] = (u32x4){0u, 0u, 0u, 0u};
                if (rr < 33 && t >= 0) xv[i] = *(const u32x4*)(H + (size_t)t * NH + O_CR + chn * 8); }
#pragma unroll
            for (int i = 0; i < 7; ++i) { const int it = tid + 512 * (7 * bt + i), rr = it / 208, chn = it - rr * 208; if (rr < 33) *(LAS u32x4*)(cin + rr * 1664 + chn * 8) = xv[i]; } }
    }
    __syncthreads();
    if (tid < 128) { const float m = mu[1536 + tid]; float prev = bf2f(cin[1536 + tid]);
#pragma unroll 4
        for (int tt = 0; tt < 32; ++tt) { const float cur = bf2f(cin[(tt + 1) * 1664 + 1536 + tid]); float xs = cur + m * (prev - cur); prev = cur;
            if (tid < 64) xs = tanhf(xs); wdad[tt * 128 + tid] = xs; } }
    __syncthreads();
    float* RR = (float*)(ws + WS_RR);
    {
        float wup[64];
        { const float* pw = in_ptr<13>() + (size_t)l * 64 * BW + c;
#pragma unroll
          for (int i = 0; i < 64; ++i) wup[i] = pw[i * BW]; }
        const float w0c = in_ptr<12>()[l * BW + c];
#pragma unroll 2
        for (int tt = 0; tt < 32; ++tt) { float dw = 0.f; const LAS f32x4* wp = (const LAS f32x4*)(wdad + tt * 128);
#pragma unroll
            for (int i4 = 0; i4 < 16; ++i4) { const f32x4 a = wp[i4]; dw += a[0] * wup[4 * i4] + a[1] * wup[4 * i4 + 1] + a[2] * wup[4 * i4 + 2] + a[3] * wup[4 * i4 + 3]; }
            const float wl = -softplusf(-(w0c + dw)) - 0.5f;
            RR[(size_t)SEQ * BW + (size_t)(t0 + tt) * BW + c] = -__expf(wl); }
    }
    asm volatile("" ::: "memory");
    {
        float aup[64];
        { const float* pa = in_ptr<15>() + (size_t)l * 64 * BW + c;
#pragma unroll
          for (int i = 0; i < 64; ++i) aup[i] = pa[i * BW]; }
        const float mr = mu[c], mk = mu[BW + c], mv = mu[2 * BW + c];
        const float a0c = in_ptr<14>()[l * BW + c], kkc = in_ptr<16>()[l * BW + c], kac = in_ptr<17>()[l * BW + c], rkc = in_ptr<18>()[l * BW + c];
        float pr = bf2f(cin[c]), pk = bf2f(cin[BW + c]), pv = bf2f(cin[2 * BW + c]);
#pragma unroll 2
        for (int tt = 0; tt < 32; ++tt) { const size_t t = (size_t)t0 + tt; const LAS bf16_t* row = cin + (tt + 1) * 1664;
            const float cr = bf2f(row[c]), ck = bf2f(row[BW + c]), cv = bf2f(row[2 * BW + c]);
            const float r = cr + mr * (pr - cr), kx = ck + mk * (pk - ck), vv = cv + mv * (pv - cv); pr = cr; pk = ck; pv = cv;
            float da = 0.f; const LAS f32x4* wp = (const LAS f32x4*)(wdad + tt * 128 + 64);
#pragma unroll
            for (int i4 = 0; i4 < 16; ++i4) { const f32x4 b = wp[i4]; da += b[0] * aup[4 * i4] + b[1] * aup[4 * i4 + 1] + b[2] * aup[4 * i4 + 2] + b[3] * aup[4 * i4 + 3]; }
            const float aicl = sigm(a0c + da);
            const float kkv = kx * kkc, ss = wave_sum_dpp(kkv * kkv), kkn = kkv / fmaxf(sqrtf(ss), 1e-12f);
            const float kc = kx * (1.f + (aicl - 1.f) * kac);
            const float bon = wave_sum_dpp(r * kc * rkc) * vv;
            const size_t o = t * BW + c;
            RR[o] = r; RR[2 * (size_t)SEQ * BW + o] = kc; RR[3 * (size_t)SEQ * BW + o] = vv;
            RR[4 * (size_t)SEQ * BW + o] = -kkn; RR[5 * (size_t)SEQ * BW + o] = kkn * aicl; RR[6 * (size_t)SEQ * BW + o] = bon;
        }
    }
    __syncthreads();
}

constexpr int LD68 = 68, MBUF = 64 * LD68 * 4;
#define MB(k) ((LAS float*)(lds + (k) * MBUF))
__device__ __forceinline__ void mm_nt(const LAS float* X, const LAS float* Y, int wave, int lane, f32x4& c0, f32x4& c1) {
    const int rs = lane & 15, kq = lane >> 4, ti = wave >> 1, tj = (wave & 1) * 2;
    const LAS f32x4* xa = (const LAS f32x4*)(X + (16 * ti + rs) * LD68 + 16 * kq);
    const LAS f32x4* y0 = (const LAS f32x4*)(Y + (16 * tj + rs) * LD68 + 16 * kq);
    const LAS f32x4* y1 = (const LAS f32x4*)(Y + (16 * tj + 16 + rs) * LD68 + 16 * kq);
    f32x4 a[4], b0[4], b1[4];
#pragma unroll
    for (int q = 0; q < 4; ++q) { a[q] = xa[q]; b0[q] = y0[q]; b1[q] = y1[q]; }
#pragma unroll
    for (int q = 0; q < 4; ++q)
#pragma unroll
        for (int e = 0; e < 4; ++e) { c0 = __builtin_amdgcn_mfma_f32_16x16x4f32(a[q][e], b0[q][e], c0, 0, 0, 0); c1 = __builtin_amdgcn_mfma_f32_16x16x4f32(a[q][e], b1[q][e], c1, 0, 0, 0); }
}
__device__ __forceinline__ void rwkv_c1_unit(int unit, LAS unsigned char* lds, int tid, int wave, int lane) {
    unsigned char* ws = ws_ptr();
    const int t0 = (unit >> 3) * 64, ch0 = (unit & 7) * 64;
    const float* RRp = (const float*)(ws + WS_RR); constexpr size_t PLn = (size_t)SEQ * BW;
    LAS float* segtot = (LAS float*)(lds + 8 * MBUF); LAS float* PL = segtot + 512;
    const int j = tid & 63, seg = wave;
    const float* gb = RRp + (size_t)(t0 + 8 * seg) * BW + ch0 + j;
#define C1_IDS int ln_ = lane; asm volatile("" : "+v"(ln_)); const int rs = ln_ & 15, kq = ln_ >> 4, ti = wave >> 1, tj = (wave & 1) * 2, row0 = 16 * ti + 4 * kq, col0 = 16 * tj + rs; \
    const int oc = row0 * LD68 + col0, otr = col0 * LD68 + row0; (void)oc; (void)otr; (void)rs; (void)kq;
    const int ow = (8 * seg) * LD68 + j;
    float lw[8], cl[8];
#pragma unroll
    for (int k = 0; k < 8; ++k) lw[k] = gb[PLn + (size_t)k * BW];
    { float run = 0.f;
#pragma unroll
      for (int k = 0; k < 8; ++k) { run += lw[k]; cl[k] = run; }
      segtot[seg * 64 + j] = run; }
    __syncthreads();
    { float off = 0.f, tot = 0.f;
#pragma unroll
      for (int s_ = 0; s_ < 8; ++s_) { const float v = segtot[s_ * 64 + j]; tot += v; off += (s_ < seg) ? v : 0.f; }
#pragma unroll
      for (int k = 0; k < 8; ++k) cl[k] += off;
      if (seg == 0) PL[j] = __expf(tot); }
#pragma unroll
    for (int k = 0; k < 8; ++k) {
        const float r = gb[(size_t)k * BW], kc = gb[2 * PLn + (size_t)k * BW], a = gb[4 * PLn + (size_t)k * BW], b = gb[5 * PLn + (size_t)k * BW];
        const float em = __expf(-cl[k]);
        MB(0)[ow + k * LD68] = a * __expf(cl[k] - lw[k]); MB(1)[ow + k * LD68] = r * __expf(cl[k]); MB(2)[ow + k * LD68] = b * em; MB(3)[ow + k * LD68] = kc * em; }
    __syncthreads();
#pragma unroll
    for (int p = 0; p < 4; ++p) { C1_IDS f32x4 c0 = (f32x4){0.f, 0.f, 0.f, 0.f}, c1 = c0;
        mm_nt(MB(p >> 1), MB(2 + (p & 1)), wave, ln_, c0, c1);
        LAS float* D = MB(4 + p) + oc;
#pragma unroll
        for (int e = 0; e < 4; ++e) { const int row = row0 + e;
            const bool k0 = (p < 2) ? (col0 < row) : (col0 <= row), k1 = (p < 2) ? (col0 + 16 < row) : (col0 + 16 <= row);
            D[e * LD68] = k0 ? c0[e] : 0.f; D[e * LD68 + 16] = k1 ? c1[e] : 0.f; } }
    __syncthreads();
    for (int idx = tid; idx < 4096; idx += NTHREADS) { const int i = idx >> 6, jx = idx & 63;
        if (i < jx) { const float u0 = MB(2)[i * LD68 + jx], u1 = MB(2)[jx * LD68 + i]; MB(2)[i * LD68 + jx] = u1; MB(2)[jx * LD68 + i] = u0; } }
    {   C1_IDS
        LAS float* xb = wave < 4 ? MB(0) + (16 * wave) * LD68 : MB(5) + (16 * (wave - 4)) * LD68;
        const LAS float* rsrc = (wave < 4 ? MB(0) + 16 * wave : MB(5) + 16 * (wave - 4)) + (4 * kq) * LD68 + rs;
        f32x4 rhs[4];
#pragma unroll
        for (int b = 0; b < 4; ++b)
#pragma unroll
            for (int e = 0; e < 4; ++e) rhs[b][e] = rsrc[(16 * b + e) * LD68];
        __syncthreads();
        LAS float* xt = xb + rs * LD68;
        const LAS float* ap = MB(4) + rs * LD68;
        int zoff = 0; asm volatile("" : "+v"(zoff));
        const LAS float* md = MB(4) + zoff;
#pragma unroll
        for (int b = 0; b < 4; ++b) {
            f32x4 cc = rhs[b];
            if (b > 0) {
#pragma unroll
                for (int g = 0; g < b; ++g) { const f32x4 av = *(const LAS f32x4*)(ap + 16 * b * LD68 + kq * 4 * b + 4 * g), bv = *(const LAS f32x4*)(xt + kq * 4 * b + 4 * g);
#pragma unroll
                    for (int e = 0; e < 4; ++e) cc = __builtin_amdgcn_mfma_f32_16x16x4f32(av[e], bv[e], cc, 0, 0, 0); } }
            *(LAS f32x4*)(xt + 16 * b + 4 * kq) = cc;
            __syncthreads();
            if (kq == 0) {
                float xx[16];
#pragma unroll
                for (int q = 0; q < 4; ++q) { const f32x4 v = *(const LAS f32x4*)(xt + 16 * b + 4 * q); xx[4 * q] = v[0]; xx[4 * q + 1] = v[1]; xx[4 * q + 2] = v[2]; xx[4 * q + 3] = v[3]; }
#pragma unroll
                for (int r = 1; r < 16; ++r) { float acc = xx[r];
#pragma unroll
                    for (int q = 0; q < (r + 3) / 4; ++q) { const f32x4 m = *(const LAS f32x4*)(md + (16 * b + r) * LD68 + 16 * b + 4 * q); acc += m[0] * xx[4 * q] + m[1] * xx[4 * q + 1] + m[2] * xx[4 * q + 2] + m[3] * xx[4 * q + 3]; }
                    xx[r] = acc; }
#pragma unroll
                for (int q = 0; q < 4; ++q) *(LAS f32x4*)(xt + 16 * b + 4 * q) = (f32x4){xx[4 * q], xx[4 * q + 1], xx[4 * q + 2], xx[4 * q + 3]};
            }
            __syncthreads();
        }
    }
    __syncthreads();
    float* gout = (float*)(ws + WS_GAMT) + (size_t)unit * 4096;
    constexpr size_t UMF = SZ_UM / 4;
    {
        C1_IDS f32x4 c0, c1;
#pragma unroll
        for (int e = 0; e < 4; ++e) { c0[e] = MB(1)[oc + e * LD68]; c1[e] = MB(1)[oc + e * LD68 + 16]; }
        mm_nt(MB(6), MB(0), wave, ln_, c0, c1);
        float* RH = gout + 2 * UMF + row0 * 64 + col0;
#pragma unroll
        for (int e = 0; e < 4; ++e) { RH[e * 64] = c0[e]; RH[e * 64 + 16] = c1[e]; } }
    {
        C1_IDS f32x4 c0, c1;
#pragma unroll
        for (int e = 0; e < 4; ++e) { c0[e] = MB(7)[oc + e * LD68]; c1[e] = MB(7)[oc + e * LD68 + 16]; }
        mm_nt(MB(6), MB(5), wave, ln_, c0, c1);
        float* WH = gout + 3 * UMF + row0 * 64 + col0;
#pragma unroll
        for (int e = 0; e < 4; ++e) { WH[e * 64] = c0[e]; WH[e * 64 + 16] = c1[e]; } }
    {
        C1_IDS f32x4 c0 = (f32x4){0.f, 0.f, 0.f, 0.f}, c1 = c0;
        mm_nt(MB(0), MB(2), wave, ln_, c0, c1);
        const float p0 = PL[col0], p1 = PL[col0 + 16];
#pragma unroll
        for (int e = 0; e < 4; ++e) { c0[e] = (c0[e] + ((row0 + e) == col0 ? 1.f : 0.f)) * p0; c1[e] = (c1[e] + ((row0 + e) == col0 + 16 ? 1.f : 0.f)) * p1; }
        float* GT = gout + col0 * 64 + row0;
        *(f32x4*)GT = c0; *(f32x4*)(GT + 16 * 64) = c1; }
    {
        C1_IDS f32x4 c0, c1;
#pragma unroll
        for (int e = 0; e < 4; ++e) { c0[e] = MB(3)[oc + e * LD68]; c1[e] = MB(3)[oc + e * LD68 + 16]; }
        mm_nt(MB(5), MB(2), wave, ln_, c0, c1);
        const float p0 = PL[col0], p1 = PL[col0 + 16];
        *(LAS f32x4*)(MB(4) + otr) = c0 * p0; *(LAS f32x4*)(MB(4) + otr + 16 * LD68) = c1 * p1; }
    float vreg[8];
#pragma unroll
    for (int k = 0; k < 8; ++k) vreg[k] = gb[3 * PLn + (size_t)k * BW];
    __syncthreads();
    *(LAS f32x4*)(MB(1) + j * LD68 + 8 * seg) = (f32x4){vreg[0], vreg[1], vreg[2], vreg[3]}; *(LAS f32x4*)(MB(1) + j * LD68 + 8 * seg + 4) = (f32x4){vreg[4], vreg[5], vreg[6], vreg[7]};
    __syncthreads();
    {
        C1_IDS f32x4 c0 = (f32x4){0.f, 0.f, 0.f, 0.f}, c1 = c0;
        mm_nt(MB(1), MB(4), wave, ln_, c0, c1);
        float* ZT = gout + UMF + col0 * 64 + row0;
        *(f32x4*)ZT = c0; *(f32x4*)(ZT + 16 * 64) = c1; }
    __syncthreads();
#undef C1_IDS
}
__device__ __forceinline__ void rwkv_chain(int unit, LAS unsigned char* lds, int tid, int wave, int lane) {
    unsigned char* ws = ws_ptr();
    const int h = unit >> 2, ti = unit & 3, tj = wave & 3, kh = wave >> 2, rs = lane & 15, kq = lane >> 4, col = 16 * tj + rs;
    const float* GT = (const float*)(ws + WS_GAMT) + (size_t)h * 4096; const float* ZT = (const float*)(ws + WS_ZT) + (size_t)h * 4096 + col * 64 + 16 * ti + 4 * kq;
    float* SST = (float*)(ws + WS_SST) + (size_t)h * 4096 + (16 * ti + 4 * kq) * 64 + col;
    constexpr size_t CS = 8 * 4096;
    constexpr int NC = SEQ / 64;
    LAS float* SB = MB(0);
    LAS f32x4* PP = (LAS f32x4*)(lds + 4 * MBUF);
    for (int i = tid; i < 16 * LD68; i += NTHREADS) SB[i] = 0.f;
    if (kh == 0) {
#pragma unroll
        for (int e = 0; e < 4; ++e) SST[e * 64] = 0.f; }
    const int q0 = tid * 4, lo0 = (tid >> 4) * LD68 + (tid & 15) * 4, lo1 = lo0 + 32 * LD68;
    { const f32x4 a0 = *(const f32x4*)(GT + q0), a1 = *(const f32x4*)(GT + q0 + 2048), b0 = *(const f32x4*)(GT + CS + q0), b1 = *(const f32x4*)(GT + CS + q0 + 2048);
      *(LAS f32x4*)(MB(1) + lo0) = a0; *(LAS f32x4*)(MB(1) + lo1) = a1; *(LAS f32x4*)(MB(2) + lo0) = b0; *(LAS f32x4*)(MB(2) + lo1) = b1; }
    f32x4 z = (f32x4){0.f, 0.f, 0.f, 0.f};
    if (kh == 0) z = *(const f32x4*)ZT;
    f32x4 gA0 = *(const f32x4*)(GT + 2 * CS + q0), gA1 = *(const f32x4*)(GT + 2 * CS + q0 + 2048), gB0, gB1;
    __syncthreads();
    const int ao = rs * LD68 + 32 * kh + 8 * kq, bo = col * LD68 + 32 * kh + 8 * kq;
#define CH_STEP(c, GL0, GL1, GW0, GW1) do { \
        const int cg = (c) + 3 < NC ? (c) + 3 : NC - 1, cz = (c) + 1 < NC ? (c) + 1 : NC - 1; \
        GL0 = *(const f32x4*)(GT + (size_t)cg * CS + q0); GL1 = *(const f32x4*)(GT + (size_t)cg * CS + q0 + 2048); \
        f32x4 zn = (f32x4){0.f, 0.f, 0.f, 0.f}; \
        if (kh == 0) zn = *(const f32x4*)(ZT + (size_t)cz * CS); \
        const LAS float* gb_ = MB(1 + (c) % 3); \
        const f32x4 a0 = *(const LAS f32x4*)(SB + ao), a1 = *(const LAS f32x4*)(SB + ao + 4), b0 = *(const LAS f32x4*)(gb_ + bo), b1 = *(const LAS f32x4*)(gb_ + bo + 4); \
        f32x4 ce = z, co = (f32x4){0.f, 0.f, 0.f, 0.f}; \
        _Pragma("unroll") for (int m = 0; m < 4; m += 2) { ce = __builtin_amdgcn_mfma_f32_16x16x4f32(a0[m], b0[m], ce, 0, 0, 0); co = __builtin_amdgcn_mfma_f32_16x16x4f32(a0[m + 1], b0[m + 1], co, 0, 0, 0); } \
        _Pragma("unroll") for (int m = 0; m < 4; m += 2) { ce = __builtin_amdgcn_mfma_f32_16x16x4f32(a1[m], b1[m], ce, 0, 0, 0); co = __builtin_amdgcn_mfma_f32_16x16x4f32(a1[m + 1], b1[m + 1], co, 0, 0, 0); } \
        f32x4 acc = ce + co; \
        if (kh == 1) PP[tj * 64 + lane] = acc; \
        __syncthreads(); \
        if (kh == 0) { acc += PP[tj * 64 + lane]; \
            _Pragma("unroll") for (int e = 0; e < 4; ++e) SB[(4 * kq + e) * LD68 + col] = acc[e]; \
            if ((c) + 1 < NC) { float* so = SST + (size_t)((c) + 1) * CS; \
                _Pragma("unroll") for (int e = 0; e < 4; ++e) so[e * 64] = acc[e]; } } \
        LAS float* gn = MB(1 + ((c) + 2) % 3); \
        *(LAS f32x4*)(gn + lo0) = GW0; *(LAS f32x4*)(gn + lo1) = GW1; \
        z = zn; \
        __syncthreads(); } while (0)
    for (int c = 0; c < NC; c += 2) { CH_STEP(c, gB0, gB1, gA0, gA1); CH_STEP(c + 1, gA0, gA1, gB0, gB1); }
#undef CH_STEP
}
#ifdef DIFFTEST
__device__ __forceinline__ float dpp_row_sum_total_(float v) {
    v += __builtin_bit_cast(float, __builtin_amdgcn_update_dpp(0, __builtin_bit_cast(int, v), 0xB1, 0xF, 0xF, true));
    v += __builtin_bit_cast(float, __builtin_amdgcn_update_dpp(0, __builtin_bit_cast(int, v), 0x4E, 0xF, 0xF, true));
    v += __builtin_bit_cast(float, __builtin_amdgcn_update_dpp(0, __builtin_bit_cast(int, v), 0x141, 0xF, 0xF, true));
    v += __builtin_bit_cast(float, __builtin_amdgcn_update_dpp(0, __builtin_bit_cast(int, v), 0x140, 0xF, 0xF, true));
    v += __builtin_bit_cast(float, __builtin_amdgcn_update_dpp(0, __builtin_bit_cast(int, v), 0x142, 0xA, 0xF, false));
    v += __builtin_bit_cast(float, __builtin_amdgcn_update_dpp(0, __builtin_bit_cast(int, v), 0x143, 0xC, 0xF, false));
    return __builtin_bit_cast(float, __builtin_amdgcn_readlane(__builtin_bit_cast(int, v), 63));
}
__device__ __forceinline__ void rwkv_naive_scan_unit(int unit, LAS unsigned char* lds, int tid, int wave, int lane) {
    unsigned char* ws = ws_ptr();
    const int h = unit >> 3, i = (unit & 7) * 8 + wave, chi = h * 64 + i;
    const size_t PL = (size_t)SEQ * BW;
    const float* RRb = (const float*)(ws + WS_RR) + h * 64 + 4 * (lane & 15) + (size_t)(lane >> 4) * BW;
    float* WY = (float*)(ws + WS_WY) + (size_t)chi * SEQ;
    constexpr int STG = 6 * 32 * 64 * 4;
    float S = 0.f;
#define RW_ISSUE(st, buf) do { _Pragma("unroll") for (int q_ = 0; q_ < 6; ++q_) { const int id_ = wave * 6 + q_, arr_ = id_ >> 3, tq_ = id_ & 7; const int pl_ = arr_ < 3 ? arr_ : (arr_ == 3 ? 3 : arr_ + 0); \
        __builtin_amdgcn_global_load_lds((const unsigned*)(RRb + (size_t)pl_ * PL + (size_t)((st) * 32 + 4 * tq_) * BW), (LAS unsigned*)(lds + (buf) * STG + (arr_ * 32 + 4 * tq_) * 256), 16, 0, 0); } } while (0)
    RW_ISSUE(0, 0);
    asm volatile("s_waitcnt vmcnt(0)" ::: "memory"); __syncthreads();
    for (int st = 0; st < SEQ / 32; ++st) {
        const int buf = st & 1;
        if (st + 1 < SEQ / 32) RW_ISSUE(st + 1, buf ^ 1);
        const LAS float* Lb = (const LAS float*)(lds + buf * STG);
        float yacc = 0.f;
#pragma unroll 8
        for (int s_ = 0; s_ < 32; ++s_) {
            const float r = Lb[(0 * 32 + s_) * 64 + lane], w = __expf(Lb[(1 * 32 + s_) * 64 + lane]), k = Lb[(2 * 32 + s_) * 64 + lane], v = Lb[(3 * 32 + s_) * 64 + i],
                        a = Lb[(4 * 32 + s_) * 64 + lane], b = Lb[(5 * 32 + s_) * 64 + lane];
            const float sa = wave_sum_dpp(S * a);
            S = S * w + (sa * b + v * k);
            const float y = wave_sum_dpp(S * r);
            yacc = (lane == s_) ? y : yacc;
        }
        if (lane < 32) WY[st * 32 + lane] = yacc;
        asm volatile("s_waitcnt vmcnt(0)" ::: "memory"); __syncthreads();
    }
#undef RW_ISSUE
}
#endif
__device__ __forceinline__ void rwkv_c3_unit(int l, int unit, LAS unsigned char* lds, int tid, int wave, int lane) {
    unsigned char* ws = ws_ptr(); const bf16_t* H = (const bf16_t*)(ws + WS_H); bf16_t* YSG = (bf16_t*)(ws + WS_YSG);
    const int t0 = (unit >> 3) * 64, ch0 = (unit & 7) * 64;
    const float* RRp = (const float*)(ws + WS_RR); const size_t PLn = (size_t)SEQ * BW;
    const size_t ub = (size_t)unit * 4096;
    const int rs = lane & 15, kq = lane >> 4, ti = wave >> 1, tj = (wave & 1) * 2, row0 = 16 * ti + 4 * kq, col0 = 16 * tj + rs, col1 = col0 + 16;
    {   const float* s0 = (const float*)(ws + WS_RH) + ub; const float* s1 = (const float*)(ws + WS_SST) + ub; const float* s2 = (const float*)(ws + WS_WH) + ub;
#pragma unroll
        for (int k = 0; k < 2; ++k) { const int q = tid + 512 * k, o = (q >> 4) * LD68 + (q & 15) * 4;
            *(LAS f32x4*)(MB(0) + o) = *(const f32x4*)(s0 + q * 4); *(LAS f32x4*)(MB(1) + o) = *(const f32x4*)(s1 + q * 4); *(LAS f32x4*)(MB(2) + o) = *(const f32x4*)(s2 + q * 4); }
        const int j = tid & 63, seg = wave; const size_t base = (size_t)(t0 + 8 * seg) * BW + ch0 + j; float vreg[8];
#pragma unroll
        for (int k = 0; k < 8; ++k) vreg[k] = RRp[3 * PLn + base + (size_t)k * BW];
        *(LAS f32x4*)(MB(3) + j * LD68 + 8 * seg) = (f32x4){vreg[0], vreg[1], vreg[2], vreg[3]}; *(LAS f32x4*)(MB(3) + j * LD68 + 8 * seg + 4) = (f32x4){vreg[4], vreg[5], vreg[6], vreg[7]}; }
    __syncthreads();
    f32x4 c0 = (f32x4){0.f, 0.f, 0.f, 0.f}, c1 = c0;
    mm_nt(MB(0), MB(1), wave, lane, c0, c1);
    mm_nt(MB(2), MB(3), wave, lane, c0, c1);
#pragma unroll
    for (int e = 0; e < 4; ++e) { MB(4)[(row0 + e) * LD68 + col0] = c0[e]; MB(4)[(row0 + e) * LD68 + col1] = c1[e]; }
    __syncthreads();
    const int ch = ch0 + lane; const float gg = in_ptr<19>()[l * BW + ch], gb = in_ptr<20>()[l * BW + ch];
    float bonv[8], gtv[8];
#pragma unroll
    for (int k = 0; k < 8; ++k) { const size_t t = (size_t)t0 + 8 * wave + k; bonv[k] = RRp[6 * PLn + t * BW + ch]; gtv[k] = bf2f(H[t * NH + O_CG + ch]); }
#pragma unroll
    for (int k = 0; k < 8; ++k) { const int tt = 8 * wave + k; const size_t t = (size_t)t0 + tt;
        float v = MB(4)[tt * LD68 + lane];
#ifdef DIFFTEST
        { const float vn = ((const float*)(ws + WS_WY))[(size_t)ch * SEQ + t]; if (DIFFCOND) v = vn; }
#endif
        const float mean = wave_sum_dpp(v) * (1.f / 64.f); const float d = v - mean; const float var = wave_sum_dpp(d * d) * (1.f / 64.f);
        const float y = d * rsqrtf(var + GN_EPS) * gg + gb + bonv[k];
        YSG[t * DM + 2 * BW + ch] = (bf16_t)f2bf(y * silu(gtv[k])); }
    __syncthreads();
}

constexpr int ATT_KS = 136, ATT_VS = 260, ATT_K_BYTES = 256 * ATT_KS * 2, ATT_V_BYTES = 128 * ATT_VS * 2;
__device__ __forceinline__ int t5_bucket(int dist) {
    if (dist < 16) return dist;
    const int thr[15] = {22, 30, 40, 54, 73, 99, 134, 182, 246, 332, 450, 609, 825, 1117, 1513};
    int b = 16;
#pragma unroll
    for (int i = 0; i < 15; ++i) b += (dist >= thr[i]) ? 1 : 0;
    return b;
}
__device__ __forceinline__ void att_unit(int unit, LAS unsigned char* lds, int tid, int wave, int lane) {
    unsigned char* ws = ws_ptr(); const bf16_t* H = (const bf16_t*)(ws + WS_H);
    const int g = unit >> 8, hh = (unit >> 6) & 3, b = unit & 63;
    const int dil = g == 0 ? 1 : (g == 1 ? 4 : 16), nb = 64 / dil, r = b / nb, n = b % nb, head = g * 4 + hh;
    LAS bf16_t* Ks = (LAS bf16_t*)lds; LAS bf16_t* Vt = (LAS bf16_t*)(lds + ATT_K_BYTES); LAS float* biasL = (LAS float*)(lds + ATT_K_BYTES + ATT_V_BYTES);
    if (tid < 176) { const int dd = tid - 16; biasL[tid] = (dd >= 0 && dd <= 128) ? in_ptr<1>()[t5_bucket(dd * dil) * 12 + head] : 0.f; }
#pragma unroll 2
    for (int it = 0; it < 8; ++it) { const int idx = it * 512 + tid, key = idx >> 4, chn = idx & 15; const int blk = n - 1 + (key >> 7);
        u32x4 kv = (u32x4){0u, 0u, 0u, 0u}, vv = (u32x4){0u, 0u, 0u, 0u};
        if (blk >= 0) { const size_t t = (size_t)r + (size_t)dil * (128 * blk + (key & 127)); const bf16_t* p = H + t * NH + head * 128 + chn * 8;
            kv = *(const u32x4*)(p + O_K); vv = *(const u32x4*)(p + O_V); }
        *(LAS u32x4*)(Ks + key * ATT_KS + chn * 8) = kv;
        LAS bf16_t* vp = Vt + (chn * 8) * ATT_VS + key;
        vp[0] = (bf16_t)(vv.x & 0xffff); vp[ATT_VS] = (bf16_t)(vv.x >> 16); vp[2 * ATT_VS] = (bf16_t)(vv.y & 0xffff); vp[3 * ATT_VS] = (bf16_t)(vv.y >> 16);
        vp[4 * ATT_VS] = (bf16_t)(vv.z & 0xffff); vp[5 * ATT_VS] = (bf16_t)(vv.z >> 16); vp[6 * ATT_VS] = (bf16_t)(vv.w & 0xffff); vp[7 * ATT_VS] = (bf16_t)(vv.w >> 16); }
    __syncthreads();
    const int fr = lane & 15, fq = lane >> 4, w = wave;
    const size_t tq = (size_t)r + (size_t)dil * (128 * n + 16 * w + fr);
    bf16x8 qf[4];
#pragma unroll
    for (int ks = 0; ks < 4; ++ks) qf[ks] = *(const bf16x8*)(H + tq * NH + O_Q + head * 128 + ks * 32 + fq * 8);
    f32x4 st[9];
#pragma unroll
    for (int kk = 0; kk < 9; ++kk) { st[kk] = (f32x4){0.f, 0.f, 0.f, 0.f}; const int kt = w + kk;
#pragma unroll
        for (int ks = 0; ks < 4; ++ks) { const bf16x8 kf = *(const LAS bf16x8*)(Ks + (16 * kt + fr) * ATT_KS + ks * 32 + fq * 8);
            st[kk] = __builtin_amdgcn_mfma_f32_16x16x32_bf16(kf, qf[ks], st[kk], 0, 0, 0); } }
    const float scale = 0.08838834764831845f; float mx = -1e30f;
    const int xo = 4 * fq - fr; const LAS float* bp = biasL + (16 + 128 - xo - 131);
#pragma unroll
    for (int kk = 0; kk < 9; ++kk) { const bool tile_ok = !(n == 0 && (w + kk) < 8);
#pragma unroll
        for (int e = 0; e < 4; ++e) { bool valid = tile_ok; if (kk == 0) valid = valid && (e + xo >= 0); if (kk == 8) valid = valid && (e + xo <= 0);
            const float lg = valid ? st[kk][e] * scale + bp[131 - (16 * kk + e)] : -1e30f; st[kk][e] = lg; mx = fmaxf(mx, lg); } }
    mx = fmaxf(mx, __shfl_xor(mx, 16)); mx = fmaxf(mx, __shfl_xor(mx, 32));
    float den = 0.f;
#pragma unroll
    for (int kk = 0; kk < 9; ++kk)
#pragma unroll
        for (int e = 0; e < 4; ++e) { const float p = __expf(st[kk][e] - mx); st[kk][e] = p; den += p; }
    den += __shfl_xor(den, 16); den += __shfl_xor(den, 32);
    f32x4 ot[8];
#pragma unroll
    for (int dt = 0; dt < 8; ++dt) ot[dt] = (f32x4){0.f, 0.f, 0.f, 0.f};
#pragma unroll
    for (int s = 0; s < 5; ++s) { const int kk0 = 2 * s, kk1 = 2 * s + 1;
        u32x4 pw; pw.x = pk2(st[kk0][0], st[kk0][1]); pw.y = pk2(st[kk0][2], st[kk0][3]);
        if (kk1 < 9) { pw.z = pk2(st[kk1 < 9 ? kk1 : 8][0], st[kk1 < 9 ? kk1 : 8][1]); pw.w = pk2(st[kk1 < 9 ? kk1 : 8][2], st[kk1 < 9 ? kk1 : 8][3]); } else { pw.z = 0u; pw.w = 0u; }
        const bf16x8 pb = __builtin_bit_cast(bf16x8, pw);
        const int kt0 = w + kk0; int kt1 = w + kk1; kt1 = kt1 > 15 ? 15 : kt1;
#pragma unroll
        for (int dt = 0; dt < 8; ++dt) { const LAS bf16_t* vr = Vt + (16 * dt + fr) * ATT_VS + 4 * fq;
            const u32x2 lo = *(const LAS u32x2*)(vr + 16 * kt0), hi = *(const LAS u32x2*)(vr + 16 * kt1);
            const u32x4 va = (u32x4){lo.x, lo.y, hi.x, hi.y};
            ot[dt] = __builtin_amdgcn_mfma_f32_16x16x32_bf16(__builtin_bit_cast(bf16x8, va), pb, ot[dt], 0, 0, 0); } }
    const float rden = 1.f / den;
    float* OG = (float*)(ws + WS_OG) + (size_t)g * SEQ * BW + tq * BW + hh * 128 + 4 * fq;
#pragma unroll
    for (int dt = 0; dt < 8; ++dt) *(f32x4*)(OG + 16 * dt) = ot[dt] * rden;
    if (fq == 0) { ((float*)(ws + WS_MG))[((size_t)g * SEQ + tq) * 4 + hh] = mx; ((float*)(ws + WS_DG))[((size_t)g * SEQ + tq) * 4 + hh] = den; }
    __syncthreads();
}
__device__ __forceinline__ void att_merge_unit(int unit, int tid) {
    unsigned char* ws = ws_ptr(); const bf16_t* H = (const bf16_t*)(ws + WS_H); bf16_t* YSG = (bf16_t*)(ws + WS_YSG);
    const float* OG = (const float*)(ws + WS_OG); const float* MG = (const float*)(ws + WS_MG); const float* DG = (const float*)(ws + WS_DG);
    const size_t t = (size_t)unit * 16 + (tid >> 5); const int c0 = (tid & 31) * 16, hh = c0 >> 7;
    float m[3], d[3];
#pragma unroll
    for (int g = 0; g < 3; ++g) { m[g] = MG[((size_t)g * SEQ + t) * 4 + hh]; d[g] = DG[((size_t)g * SEQ + t) * 4 + hh]; }
    const float mm = fmaxf(m[0], fmaxf(m[1], m[2]));
    float wt[3], ws_ = 0.f;
#pragma unroll
    for (int g = 0; g < 3; ++g) { wt[g] = __expf(m[g] - mm) * d[g]; ws_ += wt[g]; }
    const float inv = 1.f / ws_;
#pragma unroll
    for (int q = 0; q < 4; ++q) { f32x4 acc = (f32x4){0.f, 0.f, 0.f, 0.f};
#pragma unroll
        for (int g = 0; g < 3; ++g) acc += *(const f32x4*)(OG + ((size_t)g * SEQ + t) * BW + c0 + 4 * q) * wt[g];
        const u32x2 gw = *(const u32x2*)(H + t * NH + O_BG + c0 + 4 * q);
        u32x2 o; o.x = pk2(acc[0] * inv * silu(wlo(gw.x)), acc[1] * inv * silu(whi(gw.x))); o.y = pk2(acc[2] * inv * silu(wlo(gw.y)), acc[3] * inv * silu(whi(gw.y)));
        *(u32x2*)(YSG + t * DM + BW + c0 + 4 * q) = o; }
}

__device__ __forceinline__ void ln_row(const float* z, const float* g, const float* b, float* of, bf16_t* ob, int lane) {
    f32x4 v[8]; float s = 0.f;
#pragma unroll
    for (int j = 0; j < 8; ++j) { v[j] = *(const f32x4*)(z + 4 * lane + 256 * j); s += (v[j][0] + v[j][1]) + (v[j][2] + v[j][3]); }
    const float mean = wave_sum(s) * (1.f / DM); float s2 = 0.f;
#pragma unroll
    for (int j = 0; j < 8; ++j) { v[j] = v[j] - mean; s2 += (v[j][0] * v[j][0] + v[j][1] * v[j][1]) + (v[j][2] * v[j][2] + v[j][3] * v[j][3]); }
    const float rstd = rsqrtf(wave_sum(s2) * (1.f / DM) + LN_EPS);
#pragma unroll
    for (int j = 0; j < 8; ++j) { const int c = 4 * lane + 256 * j; const f32x4 gg = *(const f32x4*)(g + c), bb = *(const f32x4*)(b + c);
        const f32x4 o = v[j] * rstd * gg + bb; *(f32x4*)(of + c) = o;
        if (ob) { u32x2 w; w.x = pk2(o[0], o[1]); w.y = pk2(o[2], o[3]); *(u32x2*)(ob + c) = w; } }
}

constexpr int NPL = 8, NPHASE = 1 + DEPTH * NPL;
__global__ void __launch_bounds__(NTHREADS, 2) hybrid_fwd(Args args) {
    extern __shared__ __attribute__((aligned(16))) unsigned char lds_raw[];
    LAS unsigned char* lds = (LAS unsigned char*)lds_raw;
    const int tid0 = threadIdx.x; const int wave0 = __builtin_amdgcn_readfirstlane(tid0 >> 6);
    const int G = gridDim.x; const int bx0 = blockIdx.x;
    volatile LAS unsigned* MISC = (volatile LAS unsigned*)(lds + MISC_OFF);
    for (int u = tid0; u < (LDS_BYTES - RING_BYTES) / 4; u += NTHREADS) ((LAS unsigned*)(lds + RING_BYTES))[u] = 0u;
    __syncthreads();
    XcdBarrier bar; bar.x = 0; bar.st = nullptr;
    const bool multi = (args.ph_hi - args.ph_lo) > 1;
    if (multi) bar = xcd_barrier_post((unsigned*)(ws_ptr() + WS_CTL) + 4096, MISC + 8);

    for (int ph = args.ph_lo; ph < args.ph_hi; ++ph) {
      const int sel_ = ph == 0 ? 0 : 1 + (ph - 1) % NPL; const int nrep_ = (sel_ == RPT_SEL) ? 2 : 1;
      for (int rep_ = 0; rep_ < nrep_; ++rep_) {
#define FRESH_IDS int bx = bx0, wave = wave0; asm volatile("" : "+s"(bx)); asm volatile("" : "+s"(wave)); \
        unsigned ones_ = ~0u; asm volatile("" : "+s"(ones_)); const int lane = __builtin_amdgcn_mbcnt_hi(ones_, __builtin_amdgcn_mbcnt_lo(ones_, 0u)); \
        const int tid = wave * 64 + lane; const int vcu = (G % 8 == 0) ? (bx % 8) * (G / 8) + bx / 8 : bx; (void)tid; (void)vcu; (void)lane;
        if (ph == 0) {
            FRESH_IDS

            p0_prologue(lds, vcu, G, wave, lane, tid);
        } else {
            const int l = (ph - 1) / NPL, sp = (ph - 1) % NPL;
            if (sp == 0) {
                FRESH_IDS
                unsigned char* ws = ws_ptr();
                pg8::Gemm g{(const bf16_t*)(ws + WS_XB), (const bf16_t*)(ws + WS_WIN + l * SZ_WIN), SEQ, NPAD, DM, DM, DM};
                pg8::StaticOrder S; S.init(SEQ, NPAD, G, bx);
                pg8::EpiIn E{(bf16_t*)(ws + WS_H), (bf16_t*)(ws + WS_G), (const float*)(ws + WS_BIN) + l * NPAD};

                pg8::gemm_phase<pg8::EpiIn, pg8::StaticOrder, true>(lds, g, S, E, tid);
            } else if (sp == 1) {
                FRESH_IDS
                for (int u = vcu; u < 256; u += G) rwkv_prep_unit(l, u, lds, tid);
            } else if (sp == 2) {
                FRESH_IDS
                for (int u = vcu; u < 1024; u += G) rwkv_c1_unit(u, lds, tid, wave, lane);
            } else if (sp == 3) {
                FRESH_IDS
                if (vcu < 32) rwkv_chain(vcu, lds, tid, wave, lane);
                else { const int v2 = vcu - 32, G2 = G - 32;
#ifdef DIFFTEST
                  if (vcu < 96) rwkv_naive_scan_unit(vcu - 32, lds, tid, wave, lane);
#endif
                  for (int u = v2; u < 256; u += G2) lru_pre_unit(l, u, lds, tid);
                  for (int u = v2; u < 512; u += G2) conf_unit(l, u, lds, tid, wave, lane);
                  for (int u = v2; u < 768; u += G2) att_unit(u, lds, tid, wave, lane); }
            } else if (sp == 4) {
                FRESH_IDS
                for (int u = vcu; u < 1024; u += G) rwkv_c3_unit(l, u, lds, tid, wave, lane);
                for (int u = vcu; u < 256; u += G) lru_post_unit(u, tid);
                for (int u = vcu; u < 512; u += G) att_merge_unit(u, tid);
            } else if (sp == 5) {
                FRESH_IDS
                unsigned char* ws = ws_ptr();
                pg8::StaticOrder S; S.init(SEQ, DM, G, bx);
                const bf16_t* Gm = (const bf16_t*)(ws + WS_G); float* MIXF = (float*)(ws + WS_MIXF); bf16_t* MIX = (bf16_t*)(ws + WS_MIX);
                const bf16_t* Ab = (const bf16_t*)(ws + WS_YSG); const bf16_t* Bb = (const bf16_t*)(ws + WS_WBR + l * SZ_W2);
                { pg8::Gemm g{Ab, Bb, SEQ, DM, BW, DM, DM}; pg8::EpiMix<0> E{Gm, 0, MIXF, MIX}; pg8::gemm_phase<pg8::EpiMix<0>, pg8::StaticOrder, true>(lds, g, S, E, tid); }
                { pg8::Gemm g{Ab + BW, Bb + BW, SEQ, DM, BW, DM, DM}; pg8::EpiMix<1> E{Gm, DM, MIXF, MIX}; pg8::gemm_phase<pg8::EpiMix<1>, pg8::StaticOrder, true>(lds, g, S, E, tid); }
                { pg8::Gemm g{Ab + 2 * BW, Bb + 2 * BW, SEQ, DM, BW, DM, DM}; pg8::EpiMix<1> E{Gm, 2 * DM, MIXF, MIX}; pg8::gemm_phase<pg8::EpiMix<1>, pg8::StaticOrder, true>(lds, g, S, E, tid); }
                { pg8::Gemm g{Ab + 3 * BW, Bb + 3 * BW, SEQ, DM, BW, DM, DM}; pg8::EpiMix<2> E{Gm, 3 * DM, MIXF, MIX}; pg8::gemm_phase<pg8::EpiMix<2>, pg8::StaticOrder, true>(lds, g, S, E, tid); }
            } else if (sp == 6) {
                FRESH_IDS
                unsigned char* ws = ws_ptr();
                pg8::Gemm g{(const bf16_t*)(ws + WS_MIX), (const bf16_t*)(ws + WS_WOUT + l * SZ_W2), SEQ, DM, DM, DM, DM};
                pg8::StaticOrder S; S.init(SEQ, DM, G, bx);
                pg8::EpiOut E{l == 0 ? in_ptr<0>() : (const float*)(ws + WS_XF), (float*)(ws + WS_Z)};

                pg8::gemm_phase<pg8::EpiOut, pg8::StaticOrder, true>(lds, g, S, E, tid);
            } else {
                FRESH_IDS
                unsigned char* ws = ws_ptr();
                const float* Z = (const float*)(ws + WS_Z); const float* lg = in_ptr<27>() + l * DM; const float* lb = in_ptr<28>() + l * DM;
                float* of = l == DEPTH - 1 ? out_ptr() : (float*)(ws + WS_XF); bf16_t* ob = l == DEPTH - 1 ? nullptr : (bf16_t*)(ws + WS_XB);
                for (int row = vcu * NWAVES + wave; row < SEQ; row += G * NWAVES) ln_row(Z + (size_t)row * DM, lg, lb, of + (size_t)row * DM, ob ? ob + (size_t)row * DM : nullptr, lane);
            }
        }
        if (ph + 1 < args.ph_hi || rep_ + 1 < nrep_) { int wv_ = wave0; asm volatile("" : "+s"(wv_)); xcd_barrier(bar, wv_); }
      }
    }
}

extern "C" void kernel_launch(void* const* d_in, const int* in_sizes, int n_in, void* d_out, int out_size, void* d_ws, size_t ws_size, hipStream_t stream) {
    static int grid = 0;
    if (grid == 0) {
        if (n_in != 29 || out_size != SEQ * DM || ws_size < WS_END) { fprintf(stderr, "kernel_launch: unexpected shapes (n_in %d, out %d, ws %zu, need %zu)\n", n_in, out_size, ws_size, (size_t)WS_END); grid = -1; return; }
        int dev = 0, cus = 0;
        if (hipGetDevice(&dev) != hipSuccess || hipDeviceGetAttribute(&cus, hipDeviceAttributeMultiprocessorCount, dev) != hipSuccess) { grid = -1; return; }
        if (hipFuncSetAttribute((const void*)hybrid_fwd, hipFuncAttributeMaxDynamicSharedMemorySize, LDS_BYTES) != hipSuccess) { fprintf(stderr, "kernel_launch: hipFuncSetAttribute failed\n"); grid = -1; return; }
        int per_cu = 0;
        if (hipOccupancyMaxActiveBlocksPerMultiprocessor(&per_cu, (const void*)hybrid_fwd, NTHREADS, LDS_BYTES) != hipSuccess || per_cu < 1) fprintf(stderr, "kernel_launch: occupancy query reports %d\n", per_cu);
        (void)hipGetLastError();
        grid = cus;
    }
    if (grid < 0) return;
    (void)hipMemsetAsync((char*)d_ws + WS_CTL, 0, CTL_ZERO_BYTES, stream);
    Args a{};
    for (int i = 0; i < 29; ++i) a.in[i] = (const float*)d_in[i];
    a.out = (float*)d_out; a.ws = (unsigned char*)d_ws;
#if MK_ONE_LAUNCH
    a.ph_lo = 0; a.ph_hi = NPHASE;
    hipLaunchKernelGGL(hybrid_fwd, dim3(grid), dim3(NTHREADS), LDS_BYTES, stream, a);
#else
    for (int ph = 0; ph < NPHASE; ++ph) { a.ph_lo = ph; a.ph_hi = ph + 1; hipLaunchKernelGGL(hybrid_fwd, dim3(grid), dim3(NTHREADS), LDS_BYTES, stream, a); }
#endif
}
```
